# Optimizing an MI355X kernel written in HIP

```python
import numpy as np
import jax
import jax.numpy as jnp
from jax import lax

D_MODEL = 1024
BATCH = 8
SEQ = 2048
DEPTH = 2

D_MIX = D_MODEL
MLSTM_HEADS = 4
MLSTM_HEAD_DIM = D_MIX // 8
SB_HEADS = 4
SB_HEAD_DIM = D_MIX // 16
POOL_GROUPS = 4
POOL_CH = D_MIX // 16
POOL_WINDOWS = (2, 4, 8, 16)
W_M = MLSTM_HEADS * MLSTM_HEAD_DIM
W_SB = SB_HEADS * SB_HEAD_DIM
W_P = POOL_GROUPS * POOL_CH
MLSTM_CHUNK = 64
MLSTM_CONV = 4
SB_BLOCK = 128
FFN_CONV = 3
D_FF = ((8 * D_MODEL // 3 + 127) // 128) * 128
EPS = 1e-6
SPLIT_SIZES = (W_M, W_M, W_M, W_M, MLSTM_HEADS, MLSTM_HEADS, W_SB, W_SB, W_SB, W_P)
D_IN = sum(SPLIT_SIZES)

kernel_name = 'hybrid_mlstm_stickbreak_pool_block'


def rmsnorm(x, g):
    x32 = x.astype(jnp.float32)
    y = x32 * lax.rsqrt(jnp.mean(x32 * x32, axis=-1, keepdims=True) + EPS)
    return (y * g.astype(jnp.float32)).astype(x.dtype)


def causal_dwconv(x, w, b):
    k_width = w.shape[0]
    s = x.shape[1]
    xp = jnp.pad(x, ((0, 0), (k_width - 1, 0), (0, 0)))
    y = b
    for j in range(k_width):
        y = y + xp[:, j:j + s] * w[j]
    return y


def _mlstm_chunk(carry, xs):
    c_mat, n_vec, m_prev = carry
    q, k, v, log_f, i_log = xs
    L = q.shape[2]
    causal = jnp.tril(jnp.ones((L, L), dtype=bool))
    b = jnp.cumsum(log_f, axis=-1)
    d = jnp.where(causal, b[..., :, None] - b[..., None, :] + i_log[..., None, :], -jnp.inf)
    inter = b + m_prev[..., None]
    m_t = jnp.maximum(inter, jnp.max(d, axis=-1))
    w_inter = jnp.exp(inter - m_t)
    scores = jnp.einsum('bhtd,bhsd->bhts', q, k) * jnp.exp(d - m_t[..., None])
    num = (w_inter[..., None] * jnp.einsum('bhtd,bhde->bhte', q, c_mat)
           + jnp.einsum('bhts,bhse->bhte', scores, v))
    den = w_inter * jnp.einsum('bhtd,bhd->bht', q, n_vec) + jnp.sum(scores, axis=-1)
    h = num / jnp.maximum(jnp.abs(den), jnp.exp(-m_t))[..., None]
    b_end = b[..., -1]
    g = b_end[..., None] - b + i_log
    m_new = jnp.maximum(b_end + m_prev, jnp.max(g, axis=-1))
    decay = jnp.exp(b_end + m_prev - m_new)
    w_s = jnp.exp(g - m_new[..., None])
    c_new = decay[..., None, None] * c_mat + jnp.einsum('bhs,bhsd,bhse->bhde', w_s, k, v)
    n_new = decay[..., None] * n_vec + jnp.einsum('bhs,bhsd->bhd', w_s, k)
    return (c_new, n_new, m_new), h


def mlstm(q, k, v, i_pre, f_pre):
    bsz, s, h, dh = q.shape
    nc = s // MLSTM_CHUNK

    def to_chunks(a):
        a = a.astype(jnp.float32).reshape((bsz, nc, MLSTM_CHUNK, h) + a.shape[3:])
        return jnp.moveaxis(a, (1, 3), (0, 2))

    xs = (to_chunks(q), to_chunks(k) * (dh ** -0.5), to_chunks(v),
          to_chunks(jax.nn.log_sigmoid(f_pre.astype(jnp.float32))), to_chunks(i_pre))
    init = (jnp.zeros((bsz, h, dh, dh), jnp.float32),
            jnp.zeros((bsz, h, dh), jnp.float32),
            jnp.zeros((bsz, h), jnp.float32))
    _, hs = lax.scan(_mlstm_chunk, init, xs)
    hs = jnp.moveaxis(hs, (0, 2), (1, 3))
    return hs.reshape(bsz, s, h * dh)


def stick_breaking(q, k, v):
    bsz, s, h, d = q.shape
    qh = jnp.transpose(q, (0, 2, 1, 3)).astype(jnp.float32) * (d ** -0.5)
    kh = jnp.transpose(k, (0, 2, 1, 3)).astype(jnp.float32)
    vh = jnp.transpose(v, (0, 2, 1, 3)).astype(jnp.float32)
    s_idx = jnp.arange(s)

    def block(i):
        start = i * SB_BLOCK
        qb = lax.dynamic_slice_in_dim(qh, start, SB_BLOCK, axis=2)
        z = jnp.einsum('bhtd,bhsd->bhts', qb, kh)
        t_idx = start + jnp.arange(SB_BLOCK)
        mask = s_idx[None, :] < t_idx[:, None]
        log_1mb = jnp.where(mask, jax.nn.log_sigmoid(-z), 0.0)
        after = lax.cumsum(log_1mb, axis=3, reverse=True) - log_1mb
        a = jnp.where(mask, jnp.exp(jax.nn.log_sigmoid(z) + after), 0.0)
        return jnp.einsum('bhts,bhsd->bhtd', a, vh)

    out = lax.map(block, jnp.arange(s // SB_BLOCK))
    out = jnp.transpose(out, (1, 0, 3, 2, 4))
    return out.reshape(bsz, s, h * d)


def pool_mixer(u, pool_w, pool_scale):
    bsz, s, _ = u.shape
    ug = u.astype(jnp.float32).reshape(bsz, s, POOL_GROUPS, POOL_CH)
    cs = jnp.cumsum(ug, axis=1)
    pos = jnp.arange(s, dtype=jnp.float32)
    outs = []
    for g, w in enumerate(POOL_WINDOWS):
        c = cs[:, :, g]
        lag = jnp.pad(c, ((0, 0), (w, 0), (0, 0)))[:, :s]
        cnt = jnp.minimum(pos + 1.0, float(w))[None, :, None]
        outs.append((c - lag) / cnt - ug[:, :, g])
    y = jnp.stack(outs, axis=2)
    y = jnp.einsum('bsgc,gce->bsge', y, pool_w.astype(jnp.float32))
    return (y.reshape(bsz, s, W_P) * pool_scale).astype(u.dtype)


def setup_inputs(seed: int = 0) -> dict:
    key = jax.random.key(seed)
    ks = jax.random.split(key, 21)
    nrm = jax.random.normal

    def gain(k, n):
        return 1.0 + 0.05 * nrm(k, (DEPTH, n), jnp.float32)

    return {
        'x': nrm(ks[0], (BATCH, SEQ, D_MODEL), jnp.float32),
        'pre_mix_g': gain(ks[1], D_MODEL),
        'w_in': nrm(ks[2], (DEPTH, D_MODEL, D_IN), jnp.float32) * D_MODEL ** -0.5,
        'mlstm_conv_w': nrm(ks[3], (DEPTH, MLSTM_CONV, 2 * W_M), jnp.float32) * MLSTM_CONV ** -0.5,
        'mlstm_conv_b': 0.01 * nrm(ks[4], (DEPTH, 2 * W_M), jnp.float32),
        'i_bias': 0.1 * nrm(ks[5], (DEPTH, MLSTM_HEADS), jnp.float32),
        'f_bias': jnp.linspace(3.0, 6.0, MLSTM_HEADS)[None, :] + 0.1 * nrm(ks[6], (DEPTH, MLSTM_HEADS), jnp.float32),
        'pool_w': nrm(ks[7], (DEPTH, POOL_GROUPS, POOL_CH, POOL_CH), jnp.float32) * POOL_CH ** -0.5,
        'pool_scale': 1.0 + 0.1 * nrm(ks[8], (DEPTH, W_P), jnp.float32),
        'mlstm_out_g': gain(ks[9], W_M),
        'sb_out_g': gain(ks[10], W_SB),
        'pool_out_g': gain(ks[11], W_P),
        'w_out': nrm(ks[12], (DEPTH, D_MIX, D_MODEL), jnp.float32) * D_MIX ** -0.5,
        'post_mix_g': gain(ks[13], D_MODEL),
        'pre_ffn_g': gain(ks[14], D_MODEL),
        'ffn_w_up': nrm(ks[15], (DEPTH, D_MODEL, 2 * D_FF), jnp.float32) * D_MODEL ** -0.5,
        'ffn_conv_w': nrm(ks[16], (DEPTH, FFN_CONV, 2 * D_FF), jnp.float32) * FFN_CONV ** -0.5,
        'ffn_conv_b': 0.01 * nrm(ks[17], (DEPTH, 2 * D_FF), jnp.float32),
        'ffn_w_down': nrm(ks[18], (DEPTH, D_FF, D_MODEL), jnp.float32) * D_FF ** -0.5,
        'post_ffn_g': gain(ks[19], D_MODEL),
    }


def reference(x, pre_mix_g, w_in, mlstm_conv_w, mlstm_conv_b, i_bias, f_bias, pool_w, pool_scale,
              mlstm_out_g, sb_out_g, pool_out_g, w_out, post_mix_g, pre_ffn_g, ffn_w_up,
              ffn_conv_w, ffn_conv_b, ffn_w_down, post_ffn_g):
    bsz, s, _ = x.shape
    offsets = np.cumsum(SPLIT_SIZES)[:-1].tolist()
    for l in range(DEPTH):
        h = rmsnorm(x, pre_mix_g[l])
        proj = jnp.einsum('bsd,de->bse', h, w_in[l])
        q_m, k_m, v_m, o_m, i_m, f_m, q_sb, k_sb, v_sb, u_p = jnp.split(proj, offsets, axis=-1)
        qk = jax.nn.silu(causal_dwconv(jnp.concatenate([q_m, k_m], axis=-1), mlstm_conv_w[l], mlstm_conv_b[l]))
        q_m, k_m = jnp.split(qk, 2, axis=-1)
        hm = (bsz, s, MLSTM_HEADS, MLSTM_HEAD_DIM)
        y_m = mlstm(q_m.reshape(hm), k_m.reshape(hm), v_m.reshape(hm), i_m + i_bias[l], f_m + f_bias[l])
        y_m = (jax.nn.sigmoid(o_m.astype(jnp.float32)) * y_m).astype(x.dtype)
        hs = (bsz, s, SB_HEADS, SB_HEAD_DIM)
        y_sb = stick_breaking(q_sb.reshape(hs), k_sb.reshape(hs), v_sb.reshape(hs)).astype(x.dtype)
        y_p = pool_mixer(u_p, pool_w[l], pool_scale[l])
        mix = jnp.concatenate([rmsnorm(y_m, mlstm_out_g[l]), rmsnorm(y_sb, sb_out_g[l]),
                               rmsnorm(y_p, pool_out_g[l])], axis=-1)
        x = x + rmsnorm(jnp.einsum('bse,ed->bsd', mix, w_out[l]), post_mix_g[l])
        h = rmsnorm(x, pre_ffn_g[l])
        up = causal_dwconv(jnp.einsum('bsd,df->bsf', h, ffn_w_up[l]), ffn_conv_w[l], ffn_conv_b[l])
        gate, val = jnp.split(up, 2, axis=-1)
        ffn = jnp.einsum('bsf,fd->bsd', jax.nn.gelu(gate, approximate=True) * val, ffn_w_down[l])
        x = x + rmsnorm(ffn, post_ffn_g[l])
    return x
```

```cpp
#include <hip/hip_runtime.h>
#include <cstdio>
#include <cstdint>
namespace pg8 {
#define PG8_LAS __attribute__((address_space(3)))
typedef unsigned short bf16_t;
typedef short bf16x8 __attribute__((ext_vector_type(8)));
typedef float f32x4 __attribute__((ext_vector_type(4)));
typedef unsigned u32x4 __attribute__((ext_vector_type(4)));
constexpr int BM = 256, BK = 64, HALF = 128, HTB = HALF * BK * 2  , STAGE_BYTES = 8 * HTB, NXCD = 8, WGM = 8;

__host__ __device__ __forceinline__ int lds_byte(int r, int c) { const int st = (r >> 4) * 2 + (c >> 5), rr = r & 15, cc = c & 31, ob = rr * 64 + cc * 2; return st * 1024 + (ob ^ (((ob >> 9) & 1) << 5)); }
__host__ __device__ __forceinline__ void stage_rc(int b, int& R, int& C) { const int st = b / 1024, sb = b % 1024, swz = sb ^ (((sb >> 9) & 1) << 5); R = (st >> 1) * 16 + swz / 64; C = (st & 1) * 32 + (swz % 64) / 2; }
__host__ __device__ __forceinline__ int perm32(int rho) { const int n = rho >> 4, i = rho & 15; return 8 * (i >> 2) + 4 * n + (i & 3); }

struct Unit { int pm, pn; };
struct Gemm { const bf16_t* A; const bf16_t* Bt; int M, N, K; };

struct StaticOrder {
    int nM, nN, nwg, G, c;
    __host__ __device__ void init(int M, int N, int G_, int c_) { nM = M / BM; nN = N / BM; nwg = nM * nN; G = G_; c = c_; }
    __host__ __device__ bool next(int i, Unit& u) const {
        const long L = (long)i * G + c; if (L >= nwg) return false;
        int wgid = (int)L; { const int q = nwg / NXCD, r = nwg % NXCD, xcd = wgid % NXCD, off = wgid / NXCD; wgid = (xcd < r ? xcd * (q + 1) : r * (q + 1) + (xcd - r) * q) + off; }
        const int nig = WGM * nN, gid = wgid / nig, fm = gid * WGM, gsz = (nM - fm) < WGM ? (nM - fm) : WGM;
        u.pm = fm + ((wgid % nig) % gsz); u.pn = (wgid % nig) / gsz; return true;
    }
    __device__ __forceinline__ void a_ready(const Unit&) const {}
    __device__ __forceinline__ void done(const Unit&) const {}
};

__device__ __forceinline__ unsigned cvt_pk_bf16(float lo, float hi) { unsigned r; asm volatile("v_cvt_pk_bf16_f32 %0, %1, %2" : "=v"(r) : "v"(lo), "v"(hi)); return r; }
struct EpiBf16 {
    static constexpr bool PERM = true, AFTER_DRAIN = false;
    bf16_t* O; int ldc;
    __device__ __forceinline__ void operator()(const f32x4 (&acc)[2][2][4][2], const Unit& u, int wr, int wc, int fr, int fq) const {
        const int row0 = u.pm * BM + wr * 64 + fr; const int col0 = u.pn * BM + wc * 32 + 8 * fq;
#pragma unroll
        for (int ai = 0; ai < 2; ++ai)
#pragma unroll
            for (int m = 0; m < 4; ++m) { bf16_t* rowp = O + (size_t)(row0 + ai * HALF + m * 16) * ldc + col0;
#pragma unroll
                for (int bj = 0; bj < 2; ++bj) { const f32x4 v0 = acc[ai][bj][m][0], v1 = acc[ai][bj][m][1];
                    u32x4 w; w.x = cvt_pk_bf16(v0[0], v0[1]); w.y = cvt_pk_bf16(v0[2], v0[3]); w.z = cvt_pk_bf16(v1[0], v1[1]); w.w = cvt_pk_bf16(v1[2], v1[3]);
                    *(u32x4*)(rowp + bj * HALF) = w; } }
    }
};
struct EpiF32 {
    static constexpr bool PERM = false, AFTER_DRAIN = false;
    float* C; int ldc;
    __device__ __forceinline__ void operator()(const f32x4 (&acc)[2][2][4][2], const Unit& u, int wr, int wc, int fr, int fq) const {
        const int row0 = u.pm * BM + wr * 64 + fr, col0 = u.pn * BM + wc * 32 + 4 * fq;
#pragma unroll
        for (int ai = 0; ai < 2; ++ai)
#pragma unroll
            for (int m = 0; m < 4; ++m) { float* rowp = C + (size_t)(row0 + ai * HALF + m * 16) * ldc + col0;
#pragma unroll
                for (int bj = 0; bj < 2; ++bj)
#pragma unroll
                    for (int n = 0; n < 2; ++n) *(f32x4*)(rowp + bj * HALF + n * 16) = acc[ai][bj][m][n]; }
    }
};


template <class Epi, class Sched, bool ALIGN_EPI = false, bool SP2 = false>
__device__ __forceinline__ void gemm_phase(PG8_LAS unsigned char* lds, const Gemm g, const Sched& S, const Epi& E) {
    int tid_ = threadIdx.x; asm volatile("" : "+v"(tid_));
    const int tid = tid_, wid = __builtin_amdgcn_readfirstlane(tid >> 6), lane = tid & 63, wr = wid >> 2, wc = wid & 3, fr = lane & 15, fq = lane >> 4;
    const int K = g.K, nt = K / BK;
    unsigned voffA[2], voffB[2];
#pragma unroll
    for (int i = 0; i < 2; ++i) { int R, C; stage_rc(tid * 16 + i * 8192, R, C); const int Rb = Epi::PERM ? ((R & ~31) + perm32(R & 31)) : R;
        voffA[i] = (unsigned)(R * K + C) * 2u; voffB[i] = (unsigned)(Rb * K + C) * 2u; }
    const size_t kstep = (size_t)(BK * 2);
    const size_t hstep = (size_t)HALF * K * 2;
    const size_t tstep = 2 * hstep;
    const unsigned ldsw = (unsigned)wid * 1024u;
    const int aoff = lds_byte(wr * 64 + fr, fq * 8), boff = lds_byte(wc * 32 + fr, fq * 8);
#define PG8_SA(b, h) (((b) * 2 + (h)) * HTB)
#define PG8_SB(b, h) ((4 + (b) * 2 + (h)) * HTB)
#define PG8_STAGE(bufoff, gbase, voff) do { _Pragma("unroll") for (int _i = 0; _i < 2; ++_i) \
        __builtin_amdgcn_global_load_lds((const unsigned*)((const char*)(gbase) + (voff)[_i]), (PG8_LAS unsigned*)(lds + (bufoff) + ldsw + _i * 8192), 16, 0, 0); } while (0)
#define PG8_LDA(dst, b, h) do { _Pragma("unroll") for (int m = 0; m < 4; ++m) _Pragma("unroll") for (int k = 0; k < 2; ++k) dst[m][k] = *(const PG8_LAS bf16x8*)(lds + PG8_SA(b, h) + aoff + m * 2048 + k * 1024); } while (0)
#define PG8_LDB(dst, b, h) do { _Pragma("unroll") for (int n = 0; n < 2; ++n) _Pragma("unroll") for (int k = 0; k < 2; ++k) dst[n][k] = *(const PG8_LAS bf16x8*)(lds + PG8_SB(b, h) + boff + n * 2048 + k * 1024); } while (0)
#define PG8_MMA(ai, bj, At, Bt) do { __builtin_amdgcn_s_setprio(1); _Pragma("unroll") for (int m = 0; m < 4; ++m) _Pragma("unroll") for (int n = 0; n < 2; ++n) _Pragma("unroll") for (int k = 0; k < 2; ++k) \
        acc[ai][bj][m][n] = __builtin_amdgcn_mfma_f32_16x16x32_bf16(Bt[n][k], At[m][k], acc[ai][bj][m][n], 0, 0, 0); __builtin_amdgcn_s_setprio(0); } while (0)
#define PG8_WAIT_V(n) asm volatile("s_waitcnt vmcnt(" #n ")" ::: "memory")
#define PG8_WAIT_L(n) asm volatile("s_waitcnt lgkmcnt(" #n ")" ::: "memory")
#define PG8_BAR __builtin_amdgcn_s_barrier()
#define PG8_SCHED __builtin_amdgcn_sched_barrier(0)
    Unit cur, nxt; int ui = 0;
    if (!S.next(0, cur)) return;
    f32x4 acc[2][2][4][2];
#pragma unroll
    for (int a = 0; a < 2; ++a)
#pragma unroll
        for (int b = 0; b < 2; ++b)
#pragma unroll
            for (int m = 0; m < 4; ++m)
#pragma unroll
                for (int n = 0; n < 2; ++n) acc[a][b][m][n] = (f32x4){0.f, 0.f, 0.f, 0.f};
    bf16x8 At[4][2], B0[2][2], B1[2][2];
    const char* cA = (const char*)g.A + (size_t)cur.pm * tstep; const char* cB = (const char*)g.Bt + (size_t)cur.pn * tstep;
    S.a_ready(cur);
    if constexpr (SP2) {
        PG8_STAGE(PG8_SB(0, 0), cB, voffB); PG8_STAGE(PG8_SB(0, 1), cB + hstep, voffB); PG8_STAGE(PG8_SA(0, 0), cA, voffA); PG8_STAGE(PG8_SA(0, 1), cA + hstep, voffA);
        if (wr == 1) PG8_BAR;
        PG8_WAIT_V(2); PG8_BAR;
        PG8_STAGE(PG8_SB(1, 0), cB + kstep, voffB); PG8_STAGE(PG8_SA(1, 0), cA + kstep, voffA); PG8_STAGE(PG8_SB(1, 1), cB + hstep + kstep, voffB);
        PG8_WAIT_V(6); PG8_BAR;
    } else {
        PG8_STAGE(PG8_SB(0, 0), cB, voffB); PG8_STAGE(PG8_SA(0, 0), cA, voffA); PG8_STAGE(PG8_SB(0, 1), cB + hstep, voffB); PG8_STAGE(PG8_SA(0, 1), cA + hstep, voffA);
        if (wr == 1) PG8_BAR;
        PG8_WAIT_V(4); PG8_BAR;
        PG8_STAGE(PG8_SB(1, 0), cB + kstep, voffB); PG8_STAGE(PG8_SA(1, 0), cA + kstep, voffA); PG8_STAGE(PG8_SB(1, 1), cB + hstep + kstep, voffB);
        PG8_WAIT_V(6); PG8_BAR;
    }
    for (;;) {
        const bool has_next = S.next(ui + 1, nxt);
        const char* nA = has_next ? (const char*)g.A + (size_t)nxt.pm * tstep : cA; const char* nB = has_next ? (const char*)g.Bt + (size_t)nxt.pn * tstep : cB;
        for (int t = 0; t < nt; t += 2) {
            const bool last = (t == nt - 2);
            const char* a1 = cA + (size_t)(t + 1) * kstep;
            const char* a2 = last ? nA : cA + (size_t)(t + 2) * kstep; const char* b2 = last ? nB : cB + (size_t)(t + 2) * kstep;
            const char* a3 = a2 + kstep; const char* b3 = b2 + kstep;
            if (last && has_next) S.a_ready(nxt);
            if constexpr (SP2) {
            PG8_LDB(B0, 0, 0); PG8_LDB(B1, 0, 1); PG8_SCHED; PG8_LDA(At, 0, 0); PG8_STAGE(PG8_SA(1, 1), a1 + hstep, voffA);
            PG8_WAIT_V(8); PG8_WAIT_L(0); PG8_BAR; PG8_MMA(0, 0, At, B0); PG8_MMA(0, 1, At, B1); PG8_BAR; PG8_SCHED;
            PG8_LDA(At, 0, 1); PG8_STAGE(PG8_SB(0, 0), b2, voffB); PG8_STAGE(PG8_SB(0, 1), b2 + hstep, voffB); PG8_STAGE(PG8_SA(0, 0), a2, voffA);
            PG8_WAIT_V(8); PG8_WAIT_L(0); PG8_BAR; PG8_MMA(1, 0, At, B0); PG8_MMA(1, 1, At, B1); PG8_BAR; PG8_SCHED;
            PG8_LDB(B0, 1, 0); PG8_LDB(B1, 1, 1); PG8_SCHED; PG8_LDA(At, 1, 0); PG8_STAGE(PG8_SA(0, 1), a2 + hstep, voffA);
            PG8_WAIT_V(8); PG8_WAIT_L(0); PG8_BAR; PG8_MMA(0, 0, At, B0); PG8_MMA(0, 1, At, B1); PG8_BAR; PG8_SCHED;
            PG8_LDA(At, 1, 1); PG8_STAGE(PG8_SB(1, 0), b3, voffB); PG8_STAGE(PG8_SB(1, 1), b3 + hstep, voffB); PG8_STAGE(PG8_SA(1, 0), a3, voffA);
            PG8_WAIT_V(8); PG8_WAIT_L(0); PG8_BAR; PG8_MMA(1, 0, At, B0); PG8_MMA(1, 1, At, B1); PG8_BAR; PG8_SCHED;
            } else {
            PG8_LDB(B0, 0, 0); PG8_SCHED; PG8_LDA(At, 0, 0); PG8_STAGE(PG8_SA(1, 1), a1 + hstep, voffA);
            PG8_WAIT_L(8); PG8_BAR; PG8_WAIT_L(0); PG8_MMA(0, 0, At, B0); PG8_BAR; PG8_SCHED;
            PG8_LDB(B1, 0, 1); PG8_STAGE(PG8_SB(0, 0), b2, voffB);
            PG8_BAR; PG8_WAIT_L(0); PG8_MMA(0, 1, At, B1); PG8_BAR;
            PG8_LDA(At, 0, 1); PG8_STAGE(PG8_SA(0, 0), a2, voffA);
            PG8_BAR; PG8_WAIT_L(0); PG8_MMA(1, 0, At, B0); PG8_BAR; PG8_SCHED;
            PG8_STAGE(PG8_SB(0, 1), b2 + hstep, voffB);
            PG8_WAIT_V(6); PG8_BAR; PG8_MMA(1, 1, At, B1); PG8_BAR;
            PG8_LDB(B0, 1, 0); PG8_SCHED; PG8_LDA(At, 1, 0); PG8_STAGE(PG8_SA(0, 1), a2 + hstep, voffA);
            PG8_WAIT_L(8); PG8_BAR; PG8_WAIT_L(0); PG8_MMA(0, 0, At, B0); PG8_BAR; PG8_SCHED;
            PG8_LDB(B1, 1, 1); PG8_STAGE(PG8_SB(1, 0), b3, voffB);
            PG8_BAR; PG8_WAIT_L(0); PG8_MMA(0, 1, At, B1); PG8_BAR;
            PG8_LDA(At, 1, 1); PG8_STAGE(PG8_SA(1, 0), a3, voffA);
            PG8_BAR; PG8_WAIT_L(0); PG8_MMA(1, 0, At, B0); PG8_BAR; PG8_SCHED;
            PG8_STAGE(PG8_SB(1, 1), b3 + hstep, voffB);
            PG8_WAIT_V(6); PG8_BAR; PG8_MMA(1, 1, At, B1); PG8_BAR;
            }
        }
        if constexpr (ALIGN_EPI) { if (wr == 0) PG8_BAR; }
        if constexpr (!Epi::AFTER_DRAIN) { E(acc, cur, wr, wc, fr, fq); S.done(cur); }
        if (!has_next) break;
#pragma unroll
        for (int a = 0; a < 2; ++a)
#pragma unroll
            for (int b = 0; b < 2; ++b)
#pragma unroll
                for (int m = 0; m < 4; ++m)
#pragma unroll
                    for (int n = 0; n < 2; ++n) acc[a][b][m][n] = (f32x4){0.f, 0.f, 0.f, 0.f};
        cur = nxt; cA = nA; cB = nB; ++ui;
        if constexpr (ALIGN_EPI) { if (wr == 1) PG8_BAR; }
    }
    PG8_WAIT_V(0);
    if constexpr (!ALIGN_EPI) { if (wr == 0) PG8_BAR; }
    PG8_BAR;
    if constexpr (Epi::AFTER_DRAIN) { E.fused(acc, cur, wr, wc, fr, fq, lds, wid, lane); S.done(cur); }
#undef PG8_SA
#undef PG8_SB
#undef PG8_STAGE
#undef PG8_LDA
#undef PG8_LDB
#undef PG8_MMA
#undef PG8_WAIT_V
#undef PG8_WAIT_L
#undef PG8_BAR
#undef PG8_SCHED
}
}

constexpr int NWAVES = 8;
constexpr int BATCH = 8, SEQ = 2048, DM = 1024, M = BATCH * SEQ, DEPTH = 2;
constexpr int D_IN = 3080, NPROJ = 3072, DFF = 2816, NUP = 5632, NUPH = 2816;
constexpr float EPS = 1e-6f;
constexpr int PC_QM = 0, PC_KM = 512, PC_VM = 1024, PC_OM = 1536, PC_QSB = 2048, PC_KSB = 2304, PC_VSB = 2560, PC_UP = 2816;

constexpr size_t MiB = 1u << 20;
constexpr size_t WS_CTL = 0, CTL_ZERO_BYTES = 1 * MiB;
constexpr size_t WS_WIN = 1 * MiB, WS_WOUT = 7 * MiB, WS_WUP = 9 * MiB, WS_WDN = 20 * MiB;
constexpr size_t WS_XN = 26 * MiB;
constexpr size_t WS_GATES = 58 * MiB, WS_SSQ = 58 * MiB + 512 * 1024;
constexpr size_t WS_PROJ = 60 * MiB;
constexpr size_t WS_QKC = 156 * MiB;
constexpr size_t WS_MIX = 188 * MiB;
constexpr size_t WS_Y = 60 * MiB;
constexpr size_t WS_UP = 60 * MiB;
constexpr size_t WS_ACT = 148 * MiB;
constexpr size_t WS_END = 236 * MiB;
constexpr int CW_TMO = 0, CW_CODE = 1, CW_BAR = 4096;

constexpr int RING_OFF = 0, RING_BYTES = 131072;
constexpr int LDSCTL_OFF = RING_BYTES, MISC_OFF = LDSCTL_OFF + 320;
constexpr int LDS_BYTES = 147456;


#define GAS __attribute__((address_space(1)))
#define LAS __attribute__((address_space(3)))
typedef unsigned short bf16;
typedef unsigned v4u __attribute__((ext_vector_type(4)));
typedef float f32x4 __attribute__((ext_vector_type(4)));
typedef short bf16x8 __attribute__((ext_vector_type(8)));
typedef GAS unsigned gu32;
typedef GAS unsigned long long gu64;
#define RLX_AGENT __ATOMIC_RELAXED, __HIP_MEMORY_SCOPE_AGENT
#define LDS_WAIT() asm volatile("s_waitcnt lgkmcnt(0)" ::: "memory")
#define VM_WAIT() asm volatile("s_waitcnt vmcnt(0)" ::: "memory")
__device__ __forceinline__ unsigned long long rt() { return __builtin_amdgcn_s_memrealtime(); }
__device__ __forceinline__ unsigned f2bf(float f) { unsigned u = __builtin_bit_cast(unsigned, f); return (u + 0x7fffu + ((u >> 16) & 1u)) >> 16; }
__device__ __forceinline__ unsigned pk2(float lo, float hi) { return f2bf(lo) | (f2bf(hi) << 16); }

#define XB_TMO      128
#define XB_XCNT(j)  (256  + 64 * (j))
#define XB_XSUB(j)  (1280 + 64 * (j))
#define XB_XGEN(j)  (2304 + 64 * (j))
#define XB_TOP      3328
#define XB_TOPGEN   3392
#define XCD_BAR_WORDS 3456
#define XB_SPIN_CAP (1u << 18)

__device__ __forceinline__ unsigned xb_ld(unsigned* p)              { return __hip_atomic_load(p, __ATOMIC_RELAXED, __HIP_MEMORY_SCOPE_AGENT); }
__device__ __forceinline__ unsigned xb_add(unsigned* p, unsigned v) { return __hip_atomic_fetch_add(p, v, __ATOMIC_RELAXED, __HIP_MEMORY_SCOPE_AGENT); }
__device__ __forceinline__ unsigned xb_xcc_id() { return (unsigned)__builtin_amdgcn_s_getreg((3 << 11) | 20) & 0xFu; }
#define XB_SPIN(cond, bar) do { unsigned _sp = 0; while (cond) { __builtin_amdgcn_s_sleep(1); \
    if ((++_sp & 255u) == 0u) { if (xb_ld(&(bar)[XB_TMO])) break; if (_sp > XB_SPIN_CAP) { atomicAdd(&(bar)[XB_TMO], 1u); break; } } } } while (0)

struct XcdBarrier {
    unsigned* bar; unsigned x;
    volatile LAS unsigned* st;
};

__device__ __forceinline__ XcdBarrier xcd_barrier_post(unsigned* bar, volatile LAS unsigned* st) {
    XcdBarrier b; b.bar = bar; b.x = xb_xcc_id(); b.st = st;
    if (threadIdx.x == 0) (void)xb_add(&bar[XB_XCNT(b.x)], 1u);
    return b;
}
__device__ __forceinline__ void xcd_barrier_complete(unsigned* bar, unsigned x, unsigned& nloc, unsigned& nx) {
    const unsigned G = gridDim.x * gridDim.y * gridDim.z;
    unsigned sum, cnt, mine, sp = 0u;
    for (;;) {
        sum = 0u; cnt = 0u; mine = 0u;
#pragma unroll
        for (unsigned j = 0; j < 16; ++j) { const unsigned c = xb_ld(&bar[XB_XCNT(j)]); sum += c; cnt += (c > 0u) ? 1u : 0u; mine = (j == x) ? c : mine; }
        if (sum == G) break;
        __builtin_amdgcn_s_sleep(1);
        if ((++sp & 255u) == 0u) { if (xb_ld(&bar[XB_TMO])) break; if (sp > XB_SPIN_CAP) { atomicAdd(&bar[XB_TMO], 1u); break; } }
    }
    nloc = mine > 0u ? mine : 1u; nx = cnt > 0u ? cnt : 1u;
}

__device__ __forceinline__ void xcd_barrier(const XcdBarrier& b) {
    asm volatile("s_waitcnt vmcnt(0)" ::: "memory");
    __syncthreads();
    if (threadIdx.x == 0) {
        unsigned* bar = b.bar;
        __builtin_amdgcn_s_waitcnt(0);
        unsigned nloc = b.st[0], nx = b.st[1];
        if (nloc == 0u) { xcd_barrier_complete(bar, b.x, nloc, nx); b.st[0] = nloc; b.st[1] = nx; }
        const unsigned old = xb_add(&bar[XB_XSUB(b.x)], 1u);
        const unsigned gen = old / nloc;
        if (old + 1u == (gen + 1u) * nloc) {
            __builtin_amdgcn_fence(__ATOMIC_RELEASE, "agent");
            asm volatile("s_waitcnt vmcnt(0)" ::: "memory");
            const unsigned og = xb_add(&bar[XB_TOP], 1u);
            const unsigned tg = og / nx;
            if (og + 1u == (tg + 1u) * nx) xb_add(&bar[XB_TOPGEN], 1u);
            else XB_SPIN(xb_ld(&bar[XB_TOPGEN]) == tg, bar);
            __builtin_amdgcn_fence(__ATOMIC_ACQUIRE, "agent");
            xb_add(&bar[XB_XGEN(b.x)], 1u);
            asm volatile("s_waitcnt vmcnt(0)" ::: "memory");
        } else {
            XB_SPIN(xb_ld(&bar[XB_XGEN(b.x)]) == gen, bar);
            __builtin_amdgcn_fence(__ATOMIC_ACQUIRE, "agent");
            asm volatile("s_waitcnt vmcnt(0)" ::: "memory");
        }
    }
    __syncthreads();
}

typedef unsigned v2u __attribute__((ext_vector_type(2)));
struct Frame {
    LAS unsigned char* lds;
    volatile LAS unsigned* MISC;
    gu32* ctl;
    int tid, lane, wave;
    int vcu, G;
    float* out;
    unsigned char* ws;
};
__device__ __forceinline__ const float* inp(const Frame& F, int i) {
    const volatile LAS unsigned* t = (const volatile LAS unsigned*)(F.lds + LDSCTL_OFF) + 2 * i;
    const unsigned lo = __builtin_amdgcn_readfirstlane(t[0]), hi = __builtin_amdgcn_readfirstlane(t[1]);
    return (const float*)(((unsigned long long)hi << 32) | lo);
}
__device__ __forceinline__ float bflo(unsigned w) { return __uint_as_float(w << 16); }
__device__ __forceinline__ float bfhi(unsigned w) { return __uint_as_float(w & 0xffff0000u); }
__device__ __forceinline__ float bf2f(bf16 u) { return __uint_as_float((unsigned)u << 16); }
__device__ __forceinline__ float wave_sum(float v) {
#pragma unroll
    for (int o = 1; o < 64; o <<= 1) v += __shfl_xor(v, o);
    return v;
}
__device__ __forceinline__ float sigmoidf_(float x) { return 1.0f / (1.0f + __expf(-x)); }
__device__ __forceinline__ float logsigf_(float x) { return fminf(x, 0.f) - log1pf(__expf(-fabsf(x))); }

__device__ __forceinline__ void transpose_item(const float* W, int ldw, int K, bf16* WT, int n0, int c0, int k0, const float* ks, LAS float* scr, int lane) {
#pragma unroll 8
    for (int i = 0; i < 32; ++i) { const int kk = 2 * i + (lane >> 5); float v = W[(size_t)(k0 + kk) * ldw + c0 + (lane & 31)]; if (ks) v *= ks[k0 + kk]; scr[kk * 33 + (lane & 31)] = v; }
    LDS_WAIT(); asm volatile("" ::: "memory");
    const int c = lane & 7;
#pragma unroll
    for (int j = 0; j < 4; ++j) { const int n = (lane >> 3) + 8 * j; const LAS float* s = scr + (8 * c) * 33 + n;
        v4u o; o.x = pk2(s[0 * 33], s[1 * 33]); o.y = pk2(s[2 * 33], s[3 * 33]); o.z = pk2(s[4 * 33], s[5 * 33]); o.w = pk2(s[6 * 33], s[7 * 33]);
        *(GAS v4u*)(WT + (size_t)(n0 + n) * K + k0 + 8 * c) = o; }
    LDS_WAIT(); asm volatile("" ::: "memory");
}
__device__ __forceinline__ void convert_weights(Frame& F, int l) {
    LAS float* scr = (LAS float*)(F.lds + RING_OFF + F.wave * 16384);
    const int gw = F.vcu * NWAVES + F.wave, NGW = F.G * NWAVES;
    const float* w_in = inp(F, 2) + (size_t)l * DM * D_IN;
    const float* w_out = inp(F, 12) + (size_t)l * DM * DM;
    const float* w_up = inp(F, 15) + (size_t)l * DM * NUP;
    const float* w_dn = inp(F, 18) + (size_t)l * DFF * DM;
    bf16* Win_t = (bf16*)(F.ws + WS_WIN); bf16* Wout_t = (bf16*)(F.ws + WS_WOUT); bf16* Wup_t = (bf16*)(F.ws + WS_WUP); bf16* Wdn_t = (bf16*)(F.ws + WS_WDN);
    constexpr int I_IN = 16 * 96, I_OUT = 16 * 32, I_UP = 16 * 176, I_DN = 44 * 32;
    for (int it = gw; it < I_IN + I_OUT + I_UP + I_DN; it += NGW) {
        int r = it;
        if (r < I_IN) { const int kb = r / 96, nb = r % 96, n0 = 32 * nb; transpose_item(w_in, D_IN, DM, Win_t, n0, n0 < 2048 ? n0 : n0 + 8, 64 * kb, nullptr, scr, F.lane); continue; } r -= I_IN;
        if (r < I_OUT) { const int kb = r / 32, nb = r % 32, k0 = 64 * kb;
            const float* ks = k0 < 512 ? inp(F, 9) + l * 512 - 0 : (k0 < 768 ? inp(F, 10) + l * 256 - 512 : inp(F, 11) + l * 256 - 768);
            transpose_item(w_out, DM, DM, Wout_t, 32 * nb, 32 * nb, k0, ks, scr, F.lane); continue; } r -= I_OUT;
        if (r < I_UP) { const int kb = r / 176, nb = r % 176, n0 = 32 * nb, j = n0 >> 8, i = n0 & 255; const int c0 = i < 128 ? 128 * j + i : DFF + 128 * j + (i - 128);
            transpose_item(w_up, NUP, DM, Wup_t, n0, c0, 64 * kb, nullptr, scr, F.lane); continue; } r -= I_UP;
        { const int kb = r / 32, nb = r % 32; transpose_item(w_dn, DM, DFF, Wdn_t, 32 * nb, 32 * nb, 64 * kb, nullptr, scr, F.lane); }
    }
}
__device__ __forceinline__ void row_norm_store(Frame& F, const f32x4 (&v)[4], const float* g, int l, int m, bool with_gates) {
    float ss = 0.f;
#pragma unroll
    for (int j = 0; j < 4; ++j) ss += (v[j].x * v[j].x + v[j].y * v[j].y) + (v[j].z * v[j].z + v[j].w * v[j].w);
    const float rstd = 1.0f / sqrtf(wave_sum(ss) * (1.0f / DM) + EPS);
    f32x4 h[4];
    bf16* xn = (bf16*)(F.ws + WS_XN) + (size_t)m * DM;
#pragma unroll
    for (int j = 0; j < 4; ++j) { const f32x4 gg = *(const f32x4*)(g + 4 * F.lane + 256 * j); h[j] = v[j] * rstd * gg;
        v2u o; o.x = pk2(h[j].x, h[j].y); o.y = pk2(h[j].z, h[j].w); *(GAS v2u*)(xn + 4 * F.lane + 256 * j) = o; }
    if (with_gates) {
        const float* wg = inp(F, 2) + (size_t)l * DM * D_IN + 2048;
        float a[8];
#pragma unroll
        for (int e = 0; e < 8; ++e) a[e] = 0.f;
#pragma unroll
        for (int j = 0; j < 4; ++j)
#pragma unroll
            for (int e = 0; e < 4; ++e) { const int k = 4 * F.lane + 256 * j + e; const f32x4 w0 = *(const f32x4*)(wg + (size_t)k * D_IN), w1 = *(const f32x4*)(wg + (size_t)k * D_IN + 4); const float hv = h[j][e];
                a[0] += hv * w0.x; a[1] += hv * w0.y; a[2] += hv * w0.z; a[3] += hv * w0.w; a[4] += hv * w1.x; a[5] += hv * w1.y; a[6] += hv * w1.z; a[7] += hv * w1.w; }
#pragma unroll
        for (int e = 0; e < 8; ++e) a[e] = wave_sum(a[e]);
        float* gt = (float*)(F.ws + WS_GATES) + (size_t)m * 8;
        if (F.lane == 0) {
#pragma unroll
            for (int e = 0; e < 4; ++e) { gt[e] = a[e] + inp(F, 5)[l * 4 + e]; gt[4 + e] = logsigf_(a[4 + e] + inp(F, 6)[l * 4 + e]); }
        }
    }
}
__device__ __forceinline__ void p_prologue(Frame& F) {
    convert_weights(F, 0);
    const int gw = F.vcu * NWAVES + F.wave, NGW = F.G * NWAVES;
    for (int m = gw; m < M; m += NGW) {
        const GAS f32x4* xr = (const GAS f32x4*)(inp(F, 0) + (size_t)m * DM) + F.lane; f32x4 v[4];
#pragma unroll
        for (int j = 0; j < 4; ++j) v[j] = xr[64 * j];
        row_norm_store(F, v, inp(F, 1), 0, m, true);
    }
}
__device__ __forceinline__ void p_conv_pool(Frame& F, int l) {
    const bf16* PROJ = (const bf16*)(F.ws + WS_PROJ); bf16* QKC = (bf16*)(F.ws + WS_QKC); bf16* MIX = (bf16*)(F.ws + WS_MIX);
    const float* cw = inp(F, 3) + (size_t)l * 4 * 1024; const float* cb = inp(F, 4) + (size_t)l * 1024;
    const int gt = F.vcu * (NWAVES * 64) + F.tid, NGT = F.G * NWAVES * 64;
    for (int it = gt; it < M * 128; it += NGT) {
        const int m = it >> 7, c = (it & 127) * 8, s = m & (SEQ - 1);
        float a[8];
#pragma unroll
        for (int e = 0; e < 8; ++e) a[e] = cb[c + e];
#pragma unroll
        for (int j = 0; j < 4; ++j) { if (s - 3 + j >= 0) { const v4u p = *(const GAS v4u*)(PROJ + (size_t)(m - 3 + j) * NPROJ + c); const float* w = cw + j * 1024 + c;
            a[0] += w[0] * bflo(p.x); a[1] += w[1] * bfhi(p.x); a[2] += w[2] * bflo(p.y); a[3] += w[3] * bfhi(p.y); a[4] += w[4] * bflo(p.z); a[5] += w[5] * bfhi(p.z); a[6] += w[6] * bflo(p.w); a[7] += w[7] * bfhi(p.w); } }
        const float sc = c >= 512 ? 0.08838834764831845f : 1.0f;
#pragma unroll
        for (int e = 0; e < 8; ++e) a[e] = a[e] * sigmoidf_(a[e]) * sc;
        v4u o; o.x = pk2(a[0], a[1]); o.y = pk2(a[2], a[3]); o.z = pk2(a[4], a[5]); o.w = pk2(a[6], a[7]);
        *(GAS v4u*)(QKC + (size_t)m * 1024 + c) = o;
    }
    const float* pw = inp(F, 7) + (size_t)l * 4 * 64 * 64; const float* psc = inp(F, 8) + (size_t)l * 256;
    LAS float* pl = (LAS float*)(F.lds + RING_OFF + F.wave * 1024);
    const int gw = F.vcu * NWAVES + F.wave, NGW = F.G * NWAVES;
    const int g = F.lane >> 4, win = 2 << g;
    for (int m = gw; m < M; m += NGW) {
        const int s = m & (SEQ - 1); const int cnt = (s + 1) < win ? (s + 1) : win;
        float sum[4] = {0.f, 0.f, 0.f, 0.f}, u0[4];
        for (int j = 0; j < cnt; ++j) { const v2u p = *(const GAS v2u*)(PROJ + (size_t)(m - j) * NPROJ + PC_UP + 4 * F.lane); const float x0 = bflo(p.x), x1 = bfhi(p.x), x2 = bflo(p.y), x3 = bfhi(p.y);
            if (j == 0) { u0[0] = x0; u0[1] = x1; u0[2] = x2; u0[3] = x3; } sum[0] += x0; sum[1] += x1; sum[2] += x2; sum[3] += x3; }
        const float ic = 1.0f / (float)cnt;
#pragma unroll
        for (int e = 0; e < 4; ++e) pl[4 * F.lane + e] = sum[e] * ic - u0[e];
        LDS_WAIT(); asm volatile("" ::: "memory");
        f32x4 y = (f32x4){0.f, 0.f, 0.f, 0.f}; const int e4 = (F.lane & 15) * 4;
        for (int c = 0; c < 64; ++c) { const float p = pl[g * 64 + c]; const f32x4 w = *(const f32x4*)(pw + (size_t)(g * 64 + c) * 64 + e4); y += w * p; }
        const f32x4 ps = *(const f32x4*)(psc + 4 * F.lane); y = y * ps;
        const float ssq = wave_sum((y.x * y.x + y.y * y.y) + (y.z * y.z + y.w * y.w));
        const float rstd = 1.0f / sqrtf(ssq * (1.0f / 256.0f) + EPS);
        v2u o; o.x = pk2(y.x * rstd, y.y * rstd); o.y = pk2(y.z * rstd, y.w * rstd);
        *(GAS v2u*)(MIX + (size_t)m * 1024 + 768 + 4 * F.lane) = o;
        LDS_WAIT(); asm volatile("" ::: "memory");
    }
}

__device__ __forceinline__ void mlstm_unit_scalar(Frame& F, int b, int h, int qb) {
    LAS unsigned char* L = F.lds + RING_OFF;
    LAS float* Qs = (LAS float*)L;
    LAS bf16* Ks = (LAS bf16*)(L + 33792);
    LAS bf16* Vs = (LAS bf16*)(L + 33792 + 17408);
    LAS float* Ps = (LAS float*)(L + 33792 + 2 * 17408);
    LAS float* Cs = (LAS float*)(L + 33792 + 3 * 17408);
    LAS float* Rr = Cs + 2048;
    LAS float* Mr = Rr + 64;
    LAS float* Wt = Mr + 64;
    const bf16* PROJ = (const bf16*)(F.ws + WS_PROJ); const bf16* QKC = (const bf16*)(F.ws + WS_QKC); bf16* MIX = (bf16*)(F.ws + WS_MIX);
    const float* GT = (const float*)(F.ws + WS_GATES); float* SSQ = (float*)(F.ws + WS_SSQ);
    const int tid = F.tid, row = tid >> 3, sub = tid & 7, lane = F.lane, wave = F.wave;
    const int t0 = b * SEQ, q0 = qb * 64, n = q0 + 64;
    __syncthreads();
    {
        float lf[4], ig[4];
#pragma unroll
        for (int e = 0; e < 4; ++e) { const int idx = 4 * tid + e; if (idx < n) { lf[e] = GT[(size_t)(t0 + idx) * 8 + 4 + h]; ig[e] = GT[(size_t)(t0 + idx) * 8 + h]; } else { lf[e] = 0.f; ig[e] = -INFINITY; } }
        float cB[4]; cB[0] = lf[0]; cB[1] = cB[0] + lf[1]; cB[2] = cB[1] + lf[2]; cB[3] = cB[2] + lf[3];
        const float tot = cB[3]; float inc = tot;
#pragma unroll
        for (int o = 1; o < 64; o <<= 1) { const float t = __shfl_up(inc, o); if (lane >= o) inc += t; }
        if (lane == 63) Wt[wave] = inc;
        __syncthreads();
        float pre = inc - tot;
        for (int w = 0; w < wave; ++w) pre += Wt[w];
        float cc[4], cm[4];
#pragma unroll
        for (int e = 0; e < 4; ++e) { cB[e] += pre; cc[e] = ig[e] - cB[e]; }
        cm[0] = cc[0]; cm[1] = fmaxf(cm[0], cc[1]); cm[2] = fmaxf(cm[1], cc[2]); cm[3] = fmaxf(cm[2], cc[3]);
        float minc = cm[3];
#pragma unroll
        for (int o = 1; o < 64; o <<= 1) { const float t = __shfl_up(minc, o); if (lane >= o) minc = fmaxf(minc, t); }
        __syncthreads();
        if (lane == 63) Wt[wave] = minc;
        __syncthreads();
        float mpre = __shfl_up(minc, 1); if (lane == 0) mpre = -INFINITY;
        for (int w = 0; w < wave; ++w) mpre = fmaxf(mpre, Wt[w]);
#pragma unroll
        for (int e = 0; e < 4; ++e) { const int idx = 4 * tid + e; if (idx < n) { const float cmx = fmaxf(mpre, cm[e]); const float mt = cB[e] + fmaxf(0.f, cmx); Cs[idx] = cc[e];
            if (idx >= q0) { Rr[idx - q0] = cB[e] - mt; Mr[idx - q0] = mt; } } }
    }
#pragma unroll
    for (int i = 0; i < 2; ++i) { const int ch = tid + 512 * i, r = ch >> 4, c = (ch & 15) * 8; const v4u p = *(const GAS v4u*)(QKC + (size_t)(t0 + q0 + r) * 1024 + h * 128 + c);
        LAS float* d = Qs + r * 132 + c; d[0] = bflo(p.x); d[1] = bfhi(p.x); d[2] = bflo(p.y); d[3] = bfhi(p.y); d[4] = bflo(p.z); d[5] = bfhi(p.z); d[6] = bflo(p.w); d[7] = bfhi(p.w); }
    float acc[16]; float den = 0.f;
#pragma unroll
    for (int e = 0; e < 16; ++e) acc[e] = 0.f;
    for (int kt = 0; kt <= qb; ++kt) {
        __syncthreads();
#pragma unroll
        for (int i = 0; i < 2; ++i) { const int ch = tid + 512 * i, r = ch >> 4, c = (ch & 15) * 8;
            *(LAS v4u*)(Ks + r * 136 + c) = *(const GAS v4u*)(QKC + (size_t)(t0 + kt * 64 + r) * 1024 + 512 + h * 128 + c);
            *(LAS v4u*)(Vs + r * 136 + c) = *(const GAS v4u*)(PROJ + (size_t)(t0 + kt * 64 + r) * NPROJ + PC_VM + h * 128 + c); }
        __syncthreads();
        float s[8];
#pragma unroll
        for (int i = 0; i < 8; ++i) s[i] = 0.f;
        for (int d = 0; d < 128; d += 4) { const f32x4 q = *(const LAS f32x4*)(Qs + row * 132 + d);
#pragma unroll
            for (int i = 0; i < 8; ++i) { const v2u k = *(const LAS v2u*)(Ks + (sub * 8 + i) * 136 + d); s[i] += q.x * bflo(k.x) + q.y * bfhi(k.x) + q.z * bflo(k.y) + q.w * bfhi(k.y); } }
        const float rr = Rr[row];
#pragma unroll
        for (int i = 0; i < 8; ++i) { const int key = sub * 8 + i; const float w = (kt * 64 + key <= q0 + row) ? s[i] * __expf(rr + Cs[kt * 64 + key]) : 0.f; den += w; Ps[row * 68 + key] = w; }
        __syncthreads();
        for (int key = 0; key < 64; ++key) { const float p = Ps[row * 68 + key]; const v4u v0 = *(const LAS v4u*)(Vs + key * 136 + sub * 16), v1 = *(const LAS v4u*)(Vs + key * 136 + sub * 16 + 8);
            acc[0] += p * bflo(v0.x); acc[1] += p * bfhi(v0.x); acc[2] += p * bflo(v0.y); acc[3] += p * bfhi(v0.y); acc[4] += p * bflo(v0.z); acc[5] += p * bfhi(v0.z); acc[6] += p * bflo(v0.w); acc[7] += p * bfhi(v0.w);
            acc[8] += p * bflo(v1.x); acc[9] += p * bfhi(v1.x); acc[10] += p * bflo(v1.y); acc[11] += p * bfhi(v1.y); acc[12] += p * bflo(v1.z); acc[13] += p * bfhi(v1.z); acc[14] += p * bflo(v1.w); acc[15] += p * bfhi(v1.w); }
    }
    den += __shfl_xor(den, 1); den += __shfl_xor(den, 2); den += __shfl_xor(den, 4);
    const float scl = 1.0f / fmaxf(fabsf(den), __expf(-Mr[row]));
    const int m = t0 + q0 + row;
    const v4u g0 = *(const GAS v4u*)(PROJ + (size_t)m * NPROJ + PC_OM + h * 128 + sub * 16), g1 = *(const GAS v4u*)(PROJ + (size_t)m * NPROJ + PC_OM + h * 128 + sub * 16 + 8);
    float og[16] = {bflo(g0.x), bfhi(g0.x), bflo(g0.y), bfhi(g0.y), bflo(g0.z), bfhi(g0.z), bflo(g0.w), bfhi(g0.w), bflo(g1.x), bfhi(g1.x), bflo(g1.y), bfhi(g1.y), bflo(g1.z), bfhi(g1.z), bflo(g1.w), bfhi(g1.w)};
    float ssq = 0.f;
#pragma unroll
    for (int e = 0; e < 16; ++e) { acc[e] = acc[e] * scl * sigmoidf_(og[e]); ssq += acc[e] * acc[e]; }
    v4u o0, o1; o0.x = pk2(acc[0], acc[1]); o0.y = pk2(acc[2], acc[3]); o0.z = pk2(acc[4], acc[5]); o0.w = pk2(acc[6], acc[7]); o1.x = pk2(acc[8], acc[9]); o1.y = pk2(acc[10], acc[11]); o1.z = pk2(acc[12], acc[13]); o1.w = pk2(acc[14], acc[15]);
    *(GAS v4u*)(MIX + (size_t)m * 1024 + h * 128 + sub * 16) = o0; *(GAS v4u*)(MIX + (size_t)m * 1024 + h * 128 + sub * 16 + 8) = o1;
    ssq += __shfl_xor(ssq, 1); ssq += __shfl_xor(ssq, 2); ssq += __shfl_xor(ssq, 4);
    if (sub == 0) SSQ[(size_t)m * 8 + h] = ssq;
}
__device__ __forceinline__ void sb_unit_scalar(Frame& F, int b, int h, int qb) {
    LAS unsigned char* L = F.lds + RING_OFF;
    LAS float* Qs = (LAS float*)L;
    LAS bf16* Ks = (LAS bf16*)(L + 17408);
    LAS bf16* Vs = (LAS bf16*)(L + 17408 + 9216);
    LAS float* Ps = (LAS float*)(L + 17408 + 2 * 9216);
    const bf16* PROJ = (const bf16*)(F.ws + WS_PROJ); bf16* MIX = (bf16*)(F.ws + WS_MIX); float* SSQ = (float*)(F.ws + WS_SSQ);
    const int tid = F.tid, row = tid >> 3, sub = tid & 7;
    const int t0 = b * SEQ, q0 = qb * 64;
    __syncthreads();
    { const int r = tid >> 3, c = (tid & 7) * 8; const v4u p = *(const GAS v4u*)(PROJ + (size_t)(t0 + q0 + r) * NPROJ + PC_QSB + h * 64 + c);
        LAS float* d = Qs + r * 68 + c; d[0] = 0.125f * bflo(p.x); d[1] = 0.125f * bfhi(p.x); d[2] = 0.125f * bflo(p.y); d[3] = 0.125f * bfhi(p.y); d[4] = 0.125f * bflo(p.z); d[5] = 0.125f * bfhi(p.z); d[6] = 0.125f * bflo(p.w); d[7] = 0.125f * bfhi(p.w); }
    float acc[8]; float run = 0.f;
#pragma unroll
    for (int e = 0; e < 8; ++e) acc[e] = 0.f;
    for (int kt = qb; kt >= 0; --kt) {
        __syncthreads();
        { const int r = tid >> 3, c = (tid & 7) * 8;
            *(LAS v4u*)(Ks + r * 72 + c) = *(const GAS v4u*)(PROJ + (size_t)(t0 + kt * 64 + r) * NPROJ + PC_KSB + h * 64 + c);
            *(LAS v4u*)(Vs + r * 72 + c) = *(const GAS v4u*)(PROJ + (size_t)(t0 + kt * 64 + r) * NPROJ + PC_VSB + h * 64 + c); }
        __syncthreads();
        float z[8];
#pragma unroll
        for (int i = 0; i < 8; ++i) z[i] = 0.f;
        for (int d = 0; d < 64; d += 4) { const f32x4 q = *(const LAS f32x4*)(Qs + row * 68 + d);
#pragma unroll
            for (int i = 0; i < 8; ++i) { const v2u k = *(const LAS v2u*)(Ks + (sub * 8 + i) * 72 + d); z[i] += q.x * bflo(k.x) + q.y * bfhi(k.x) + q.z * bflo(k.y) + q.w * bfhi(k.y); } }
        float Lk[8], lsz[8]; bool valid[8];
#pragma unroll
        for (int i = 0; i < 8; ++i) { valid[i] = (kt * 64 + sub * 8 + i) < (q0 + row); const float sp = fmaxf(z[i], 0.f) + log1pf(__expf(-fabsf(z[i]))); Lk[i] = valid[i] ? -sp : 0.f; lsz[i] = z[i] - sp; }
        float esfx[8]; esfx[7] = 0.f;
#pragma unroll
        for (int i = 6; i >= 0; --i) esfx[i] = esfx[i + 1] + Lk[i + 1];
        const float tot = esfx[0] + Lk[0]; float inc = tot;
#pragma unroll
        for (int o = 1; o < 8; o <<= 1) { const float t = __shfl_down(inc, o, 8); if (sub + o < 8) inc += t; }
        const float excl = inc - tot;
#pragma unroll
        for (int i = 0; i < 8; ++i) { const float a = valid[i] ? __expf(lsz[i] + run + excl + esfx[i]) : 0.f; Ps[row * 68 + sub * 8 + i] = a; }
        run += __shfl(inc, 0, 8);
        __syncthreads();
        for (int key = 0; key < 64; ++key) { const float p = Ps[row * 68 + key]; const v4u v0 = *(const LAS v4u*)(Vs + key * 72 + sub * 8);
            acc[0] += p * bflo(v0.x); acc[1] += p * bfhi(v0.x); acc[2] += p * bflo(v0.y); acc[3] += p * bfhi(v0.y); acc[4] += p * bflo(v0.z); acc[5] += p * bfhi(v0.z); acc[6] += p * bflo(v0.w); acc[7] += p * bfhi(v0.w); }
    }
    const int m = t0 + q0 + row;
    float ssq = 0.f;
#pragma unroll
    for (int e = 0; e < 8; ++e) ssq += acc[e] * acc[e];
    v4u o0; o0.x = pk2(acc[0], acc[1]); o0.y = pk2(acc[2], acc[3]); o0.z = pk2(acc[4], acc[5]); o0.w = pk2(acc[6], acc[7]);
    *(GAS v4u*)(MIX + (size_t)m * 1024 + 512 + h * 64 + sub * 8) = o0;
    ssq += __shfl_xor(ssq, 1); ssq += __shfl_xor(ssq, 2); ssq += __shfl_xor(ssq, 4);
    if (sub == 0) SSQ[(size_t)m * 8 + 4 + h] = ssq;
}
__device__ __forceinline__ void p_mixers(Frame& F) {
    for (int v = F.vcu; v < 256; v += F.G) {
        const int bh = v >> 3, s = v & 7, b = bh >> 2, h = bh & 3;
        for (int i = 0; i < 4; ++i) { const int qb = (i == 0) ? s : (i == 1) ? 15 - s : (i == 2) ? 16 + s : 31 - s; mlstm_unit_scalar(F, b, h, qb); }
        for (int i = 0; i < 4; ++i) { const int qb = (i == 0) ? s : (i == 1) ? 15 - s : (i == 2) ? 16 + s : 31 - s; sb_unit_scalar(F, b, h, qb); }
    }
    __syncthreads();
}
__device__ __forceinline__ void p_groupnorm(Frame& F) {
    bf16* MIX = (bf16*)(F.ws + WS_MIX); const float* SSQ = (const float*)(F.ws + WS_SSQ);
    const int gw = F.vcu * NWAVES + F.wave, NGW = F.G * NWAVES;
    for (int m = gw; m < M; m += NGW) {
        const f32x4 a = *(const f32x4*)(SSQ + (size_t)m * 8), c = *(const f32x4*)(SSQ + (size_t)m * 8 + 4);
        const float rm = 1.0f / sqrtf(((a.x + a.y) + (a.z + a.w)) * (1.0f / 512.0f) + EPS), rs = 1.0f / sqrtf(((c.x + c.y) + (c.z + c.w)) * (1.0f / 256.0f) + EPS);
#pragma unroll
        for (int i = 0; i < 2; ++i) { const int ch = F.lane + 64 * i; if (ch < 96) { GAS v4u* p = (GAS v4u*)(MIX + (size_t)m * 1024 + ch * 8); const v4u x = *p; const float r = ch < 64 ? rm : rs;
            v4u o; o.x = pk2(bflo(x.x) * r, bfhi(x.x) * r); o.y = pk2(bflo(x.y) * r, bfhi(x.y) * r); o.z = pk2(bflo(x.z) * r, bfhi(x.z) * r); o.w = pk2(bflo(x.w) * r, bfhi(x.w) * r); *p = o; } }
    }
}
__device__ __forceinline__ void p_rowpass(Frame& F, const float* base, const float* g1, const float* g2, int lg, bool with_gates) {
    const float* Y = (const float*)(F.ws + WS_Y);
    const int gw = F.vcu * NWAVES + F.wave, NGW = F.G * NWAVES;
    for (int m = gw; m < M; m += NGW) {
        const GAS f32x4* yr = (const GAS f32x4*)(Y + (size_t)m * DM) + F.lane; const GAS f32x4* br = (const GAS f32x4*)(base + (size_t)m * DM) + F.lane;
        f32x4 y[4], v[4]; float ss = 0.f;
#pragma unroll
        for (int j = 0; j < 4; ++j) { y[j] = yr[64 * j]; v[j] = br[64 * j]; ss += (y[j].x * y[j].x + y[j].y * y[j].y) + (y[j].z * y[j].z + y[j].w * y[j].w); }
        const float rstd = 1.0f / sqrtf(wave_sum(ss) * (1.0f / DM) + EPS);
        GAS f32x4* orow = (GAS f32x4*)(F.out + (size_t)m * DM) + F.lane;
#pragma unroll
        for (int j = 0; j < 4; ++j) { const f32x4 gg = *(const f32x4*)(g1 + 4 * F.lane + 256 * j); v[j] = v[j] + y[j] * rstd * gg; orow[64 * j] = v[j]; }
        if (g2) row_norm_store(F, v, g2, lg, m, with_gates);
    }
}
__device__ __forceinline__ void p_act(Frame& F, int l, int f_off) {
    const bf16* UP = (const bf16*)(F.ws + WS_UP); bf16* ACT = (bf16*)(F.ws + WS_ACT);
    const float* cw = inp(F, 16) + (size_t)l * 3 * NUP; const float* cb = inp(F, 17) + (size_t)l * NUP;
    const int gt = F.vcu * (NWAVES * 64) + F.tid, NGT = F.G * NWAVES * 64;
    for (int it = gt; it < M * 176; it += NGT) {
        const int m = it / 176, c = it % 176, j = c >> 4, ii = (c & 15) * 8, s = m & (SEQ - 1);
        const int f = f_off + 128 * j + ii;
        float ga[8], va[8];
#pragma unroll
        for (int e = 0; e < 8; ++e) { ga[e] = cb[f + e]; va[e] = cb[DFF + f + e]; }
#pragma unroll
        for (int jj = 0; jj < 3; ++jj) { if (s - 2 + jj >= 0) { const bf16* rp = UP + (size_t)(m - 2 + jj) * NUPH + 256 * j + ii; const v4u pg = *(const GAS v4u*)rp, pv = *(const GAS v4u*)(rp + 128);
            const float* wg = cw + (size_t)jj * NUP + f; const float* wv = wg + DFF;
            ga[0] += wg[0] * bflo(pg.x); ga[1] += wg[1] * bfhi(pg.x); ga[2] += wg[2] * bflo(pg.y); ga[3] += wg[3] * bfhi(pg.y); ga[4] += wg[4] * bflo(pg.z); ga[5] += wg[5] * bfhi(pg.z); ga[6] += wg[6] * bflo(pg.w); ga[7] += wg[7] * bfhi(pg.w);
            va[0] += wv[0] * bflo(pv.x); va[1] += wv[1] * bfhi(pv.x); va[2] += wv[2] * bflo(pv.y); va[3] += wv[3] * bfhi(pv.y); va[4] += wv[4] * bflo(pv.z); va[5] += wv[5] * bfhi(pv.z); va[6] += wv[6] * bflo(pv.w); va[7] += wv[7] * bfhi(pv.w); } }
        float o[8];
#pragma unroll
        for (int e = 0; e < 8; ++e) { const float x = ga[e]; const float u2 = 1.5957691216057308f * (x + 0.044715f * x * x * x); o[e] = x * sigmoidf_(u2) * va[e]; }
        v4u ov; ov.x = pk2(o[0], o[1]); ov.y = pk2(o[2], o[3]); ov.z = pk2(o[4], o[5]); ov.w = pk2(o[6], o[7]);
        *(GAS v4u*)(ACT + (size_t)m * DFF + f) = ov;
    }
}


#define GRID_BAR() xcd_barrier(bar)
template <int l> __device__ __forceinline__ void layer_fwd(Frame& F, const XcdBarrier& bar) {
    bf16* XN = (bf16*)(F.ws + WS_XN); bf16* PROJ = (bf16*)(F.ws + WS_PROJ); bf16* MIX = (bf16*)(F.ws + WS_MIX); bf16* UP = (bf16*)(F.ws + WS_UP); bf16* ACT = (bf16*)(F.ws + WS_ACT); float* Y = (float*)(F.ws + WS_Y);
    bf16* Win_t = (bf16*)(F.ws + WS_WIN); bf16* Wout_t = (bf16*)(F.ws + WS_WOUT); bf16* Wup_t = (bf16*)(F.ws + WS_WUP); bf16* Wdn_t = (bf16*)(F.ws + WS_WDN);

        {
            pg8::Gemm g{XN, Win_t, M, NPROJ, DM}; pg8::StaticOrder S; S.init(M, NPROJ, F.G, (int)blockIdx.x);
            pg8::EpiBf16 E{PROJ, NPROJ};
            pg8::gemm_phase<pg8::EpiBf16, pg8::StaticOrder, true, true>(F.lds + RING_OFF, g, S, E);
        }
        GRID_BAR();
#ifndef NO_P_CONV_POOL
        p_conv_pool(F, l);
#endif
        GRID_BAR();
#ifndef NO_P_MIXERS
        p_mixers(F);
#endif
        GRID_BAR();
#ifndef NO_P_GROUPNORM
        p_groupnorm(F);
#endif
        GRID_BAR();
        {
            pg8::Gemm g{MIX, Wout_t, M, DM, DM}; pg8::StaticOrder S; S.init(M, DM, F.G, (int)blockIdx.x);
            pg8::EpiF32 E{Y, DM};
            pg8::gemm_phase<pg8::EpiF32, pg8::StaticOrder, true, true>(F.lds + RING_OFF, g, S, E);
        }
        GRID_BAR();
        p_rowpass(F, l == 0 ? inp(F, 0) : F.out, inp(F, 13) + l * DM, inp(F, 14) + l * DM, l, false);
        GRID_BAR();
        {
            constexpr int hf = 0;
            {
                pg8::Gemm g{XN, Wup_t + (size_t)hf * NUPH * DM, M, NUPH, DM}; pg8::StaticOrder S; S.init(M, NUPH, F.G, (int)blockIdx.x);
                pg8::EpiBf16 E{UP, NUPH};
                pg8::gemm_phase<pg8::EpiBf16, pg8::StaticOrder, true, true>(F.lds + RING_OFF, g, S, E);
            }
            GRID_BAR();
    #ifndef NO_P_ACT
        p_act(F, l, hf * 1408);
#endif
            GRID_BAR();
        }
        {
            constexpr int hf = 1;
            {
                pg8::Gemm g{XN, Wup_t + (size_t)hf * NUPH * DM, M, NUPH, DM}; pg8::StaticOrder S; S.init(M, NUPH, F.G, (int)blockIdx.x);
                pg8::EpiBf16 E{UP, NUPH};
                pg8::gemm_phase<pg8::EpiBf16, pg8::StaticOrder, true, true>(F.lds + RING_OFF, g, S, E);
            }
            GRID_BAR();
    #ifndef NO_P_ACT
        p_act(F, l, hf * 1408);
#endif
            GRID_BAR();
        }
        {
            pg8::Gemm g{ACT, Wdn_t, M, DM, DFF}; pg8::StaticOrder S; S.init(M, DM, F.G, (int)blockIdx.x);
            pg8::EpiF32 E{Y, DM};
            pg8::gemm_phase<pg8::EpiF32, pg8::StaticOrder, true, true>(F.lds + RING_OFF, g, S, E);
        }
        GRID_BAR();
        if (l + 1 < DEPTH) {
            p_rowpass(F, F.out, inp(F, 19) + l * DM, inp(F, 1) + (l + 1) * DM, l + 1, true);
            convert_weights(F, l + 1);
            GRID_BAR();
        } else {
            p_rowpass(F, F.out, inp(F, 19) + l * DM, nullptr, 0, false);
        }
    }
#undef GRID_BAR
struct Args { const float* in[20]; float* out; unsigned char* ws; };
__global__ void __launch_bounds__(NWAVES * 64, 2) mega_fwd(Args args) {
    extern __shared__ __attribute__((aligned(16))) unsigned char lds[];
    Frame F;
    F.lds = (LAS unsigned char*)lds;
    F.MISC = (volatile LAS unsigned*)(F.lds + MISC_OFF);
    F.tid = threadIdx.x; F.lane = F.tid & 63; F.wave = __builtin_amdgcn_readfirstlane(F.tid >> 6);
    F.G = gridDim.x; { const int bx = blockIdx.x; F.vcu = (F.G % 8 == 0) ? (bx % 8) * (F.G / 8) + bx / 8 : bx; }
    F.ws = args.ws; F.out = args.out; F.ctl = (gu32*)(args.ws + WS_CTL);
    for (int u = F.tid; u < (LDS_BYTES - LDSCTL_OFF) / 4; u += NWAVES * 64) ((LAS unsigned*)(F.lds + LDSCTL_OFF))[u] = 0u;
    __syncthreads();
    if (F.tid == 0) { LAS unsigned long long* t = (LAS unsigned long long*)(F.lds + LDSCTL_OFF);
#define PUT_(i) t[i] = (unsigned long long)args.in[i];
        PUT_(0) PUT_(1) PUT_(2) PUT_(3) PUT_(4) PUT_(5) PUT_(6) PUT_(7) PUT_(8) PUT_(9) PUT_(10) PUT_(11) PUT_(12) PUT_(13) PUT_(14) PUT_(15) PUT_(16) PUT_(17) PUT_(18) PUT_(19)
#undef PUT_
    }
    __syncthreads();
    XcdBarrier bar = xcd_barrier_post((unsigned*)(F.ctl + CW_BAR), F.MISC + 8);
#define GRID_BAR() xcd_barrier(bar)
#ifndef NO_P_PROLOGUE
        p_prologue(F);
#endif
    GRID_BAR();
    layer_fwd<0>(F, bar);
    layer_fwd<1>(F, bar);
#undef GRID_BAR
}

extern "C" void kernel_launch(void* const* d_in, const int* in_sizes, int n_in, void* d_out, int out_size, void* d_ws, size_t ws_size, hipStream_t stream) {
    static int grid = 0;
    if (grid == 0) {
        if (n_in != 20 || in_sizes[0] != M * DM || out_size != M * DM || ws_size < WS_END) { fprintf(stderr, "kernel_launch: unexpected shapes (n_in %d, in0 %d, out %d, ws %zu)\n", n_in, n_in > 0 ? in_sizes[0] : -1, out_size, ws_size); grid = -1; return; }
        int dev = 0, cus = 0, per_cu = 0;
        if (hipGetDevice(&dev) != hipSuccess || hipDeviceGetAttribute(&cus, hipDeviceAttributeMultiprocessorCount, dev) != hipSuccess) { grid = -1; return; }
        if (hipFuncSetAttribute((const void*)mega_fwd, hipFuncAttributeMaxDynamicSharedMemorySize, LDS_BYTES) != hipSuccess) { fprintf(stderr, "kernel_launch: hipFuncSetAttribute failed\n"); grid = -1; return; }
        if (hipOccupancyMaxActiveBlocksPerMultiprocessor(&per_cu, (const void*)mega_fwd, NWAVES * 64, LDS_BYTES) != hipSuccess || per_cu < 1) fprintf(stderr, "kernel_launch: occupancy query reports %d blocks per CU\n", per_cu);
        (void)hipGetLastError();
        grid = cus;
    }
    if (grid < 0) return;
    if (hipMemsetAsync((char*)d_ws + WS_CTL, 0, CTL_ZERO_BYTES, stream) != hipSuccess) { fprintf(stderr, "kernel_launch: hipMemsetAsync failed\n"); return; }
    Args a{};
    for (int i = 0; i < 20; ++i) a.in[i] = (const float*)d_in[i];
    a.out = (float*)d_out; a.ws = (unsigned char*)d_ws;
    hipLaunchKernelGGL(mega_fwd, dim3(grid), dim3(NWAVES * 64), LDS_BYTES, stream, a);
    const hipError_t le = hipPeekAtLastError();
    if (le != hipSuccess) fprintf(stderr, "kernel_launch: launch failed: %s\n", hipGetErrorName(le));
}
```

```cpp
#include <hip/hip_runtime.h>
#include <cstdio>
#include <cstdint>
namespace pg8 {
#define PG8_LAS __attribute__((address_space(3)))
typedef unsigned short bf16_t;
typedef short bf16x8 __attribute__((ext_vector_type(8)));
typedef float f32x4 __attribute__((ext_vector_type(4)));
typedef unsigned u32x4 __attribute__((ext_vector_type(4)));
constexpr int BM = 256, BK = 64, HALF = 128, HTB = HALF * BK * 2  , STAGE_BYTES = 8 * HTB, NXCD = 8, WGM = 8;

__host__ __device__ __forceinline__ int lds_byte(int r, int c) { const int st = (r >> 4) * 2 + (c >> 5), rr = r & 15, cc = c & 31, ob = rr * 64 + cc * 2; return st * 1024 + (ob ^ (((ob >> 9) & 1) << 5)); }
__host__ __device__ __forceinline__ void stage_rc(int b, int& R, int& C) { const int st = b / 1024, sb = b % 1024, swz = sb ^ (((sb >> 9) & 1) << 5); R = (st >> 1) * 16 + swz / 64; C = (st & 1) * 32 + (swz % 64) / 2; }
__host__ __device__ __forceinline__ int perm32(int rho) { const int n = rho >> 4, i = rho & 15; return 8 * (i >> 2) + 4 * n + (i & 3); }

struct Unit { int pm, pn; };
struct Gemm { const bf16_t* A; const bf16_t* Bt; int M, N, K; };

struct StaticOrder {
    int nM, nN, nwg, G, c;
    __host__ __device__ void init(int M, int N, int G_, int c_) { nM = M / BM; nN = N / BM; nwg = nM * nN; G = G_; c = c_; }
    __host__ __device__ bool next(int i, Unit& u) const {
        const long L = (long)i * G + c; if (L >= nwg) return false;
        int wgid = (int)L; { const int q = nwg / NXCD, r = nwg % NXCD, xcd = wgid % NXCD, off = wgid / NXCD; wgid = (xcd < r ? xcd * (q + 1) : r * (q + 1) + (xcd - r) * q) + off; }
        const int nig = WGM * nN, gid = wgid / nig, fm = gid * WGM, gsz = (nM - fm) < WGM ? (nM - fm) : WGM;
        u.pm = fm + ((wgid % nig) % gsz); u.pn = (wgid % nig) / gsz; return true;
    }
    __device__ __forceinline__ void a_ready(const Unit&) const {}
    __device__ __forceinline__ void done(const Unit&) const {}
};

__device__ __forceinline__ unsigned cvt_pk_bf16(float lo, float hi) { unsigned r; asm volatile("v_cvt_pk_bf16_f32 %0, %1, %2" : "=v"(r) : "v"(lo), "v"(hi)); return r; }
struct EpiBf16 {
    static constexpr bool PERM = true, AFTER_DRAIN = false;
    bf16_t* O; int ldc;
    __device__ __forceinline__ void operator()(const f32x4 (&acc)[2][2][4][2], const Unit& u, int wr, int wc, int fr, int fq) const {
        const int row0 = u.pm * BM + wr * 64 + fr; const int col0 = u.pn * BM + wc * 32 + 8 * fq;
#pragma unroll
        for (int ai = 0; ai < 2; ++ai)
#pragma unroll
            for (int m = 0; m < 4; ++m) { bf16_t* rowp = O + (size_t)(row0 + ai * HALF + m * 16) * ldc + col0;
#pragma unroll
                for (int bj = 0; bj < 2; ++bj) { const f32x4 v0 = acc[ai][bj][m][0], v1 = acc[ai][bj][m][1];
                    u32x4 w; w.x = cvt_pk_bf16(v0[0], v0[1]); w.y = cvt_pk_bf16(v0[2], v0[3]); w.z = cvt_pk_bf16(v1[0], v1[1]); w.w = cvt_pk_bf16(v1[2], v1[3]);
                    *(u32x4*)(rowp + bj * HALF) = w; } }
    }
};
struct EpiF32 {
    static constexpr bool PERM = false, AFTER_DRAIN = false;
    float* C; int ldc;
    __device__ __forceinline__ void operator()(const f32x4 (&acc)[2][2][4][2], const Unit& u, int wr, int wc, int fr, int fq) const {
        const int row0 = u.pm * BM + wr * 64 + fr, col0 = u.pn * BM + wc * 32 + 4 * fq;
#pragma unroll
        for (int ai = 0; ai < 2; ++ai)
#pragma unroll
            for (int m = 0; m < 4; ++m) { float* rowp = C + (size_t)(row0 + ai * HALF + m * 16) * ldc + col0;
#pragma unroll
                for (int bj = 0; bj < 2; ++bj)
#pragma unroll
                    for (int n = 0; n < 2; ++n) *(f32x4*)(rowp + bj * HALF + n * 16) = acc[ai][bj][m][n]; }
    }
};


template <class Epi, class Sched, bool ALIGN_EPI = false, bool SP2 = false>
__device__ __forceinline__ void gemm_phase(PG8_LAS unsigned char* lds, const Gemm g, const Sched& S, const Epi& E) {
    int tid_ = threadIdx.x; asm volatile("" : "+v"(tid_));
    const int tid = tid_, wid = __builtin_amdgcn_readfirstlane(tid >> 6), lane = tid & 63, wr = wid >> 2, wc = wid & 3, fr = lane & 15, fq = lane >> 4;
    const int K = g.K, nt = K / BK;
    unsigned voffA[2], voffB[2];
#pragma unroll
    for (int i = 0; i < 2; ++i) { int R, C; stage_rc(tid * 16 + i * 8192, R, C); const int Rb = Epi::PERM ? ((R & ~31) + perm32(R & 31)) : R;
        voffA[i] = (unsigned)(R * K + C) * 2u; voffB[i] = (unsigned)(Rb * K + C) * 2u; }
    const size_t kstep = (size_t)(BK * 2);
    const size_t hstep = (size_t)HALF * K * 2;
    const size_t tstep = 2 * hstep;
    const unsigned ldsw = (unsigned)wid * 1024u;
    const int aoff = lds_byte(wr * 64 + fr, fq * 8), boff = lds_byte(wc * 32 + fr, fq * 8);
#define PG8_SA(b, h) (((b) * 2 + (h)) * HTB)
#define PG8_SB(b, h) ((4 + (b) * 2 + (h)) * HTB)
#define PG8_STAGE(bufoff, gbase, voff) do { _Pragma("unroll") for (int _i = 0; _i < 2; ++_i) \
        __builtin_amdgcn_global_load_lds((const unsigned*)((const char*)(gbase) + (voff)[_i]), (PG8_LAS unsigned*)(lds + (bufoff) + ldsw + _i * 8192), 16, 0, 0); } while (0)
#define PG8_LDA(dst, b, h) do { _Pragma("unroll") for (int m = 0; m < 4; ++m) _Pragma("unroll") for (int k = 0; k < 2; ++k) dst[m][k] = *(const PG8_LAS bf16x8*)(lds + PG8_SA(b, h) + aoff + m * 2048 + k * 1024); } while (0)
#define PG8_LDB(dst, b, h) do { _Pragma("unroll") for (int n = 0; n < 2; ++n) _Pragma("unroll") for (int k = 0; k < 2; ++k) dst[n][k] = *(const PG8_LAS bf16x8*)(lds + PG8_SB(b, h) + boff + n * 2048 + k * 1024); } while (0)
#define PG8_MMA(ai, bj, At, Bt) do { __builtin_amdgcn_s_setprio(1); _Pragma("unroll") for (int m = 0; m < 4; ++m) _Pragma("unroll") for (int n = 0; n < 2; ++n) _Pragma("unroll") for (int k = 0; k < 2; ++k) \
        acc[ai][bj][m][n] = __builtin_amdgcn_mfma_f32_16x16x32_bf16(Bt[n][k], At[m][k], acc[ai][bj][m][n], 0, 0, 0); __builtin_amdgcn_s_setprio(0); } while (0)
#define PG8_WAIT_V(n) asm volatile("s_waitcnt vmcnt(" #n ")" ::: "memory")
#define PG8_WAIT_L(n) asm volatile("s_waitcnt lgkmcnt(" #n ")" ::: "memory")
#define PG8_BAR __builtin_amdgcn_s_barrier()
#define PG8_SCHED __builtin_amdgcn_sched_barrier(0)
    Unit cur, nxt; int ui = 0;
    if (!S.next(0, cur)) return;
    f32x4 acc[2][2][4][2];
#pragma unroll
    for (int a = 0; a < 2; ++a)
#pragma unroll
        for (int b = 0; b < 2; ++b)
#pragma unroll
            for (int m = 0; m < 4; ++m)
#pragma unroll
                for (int n = 0; n < 2; ++n) acc[a][b][m][n] = (f32x4){0.f, 0.f, 0.f, 0.f};
    bf16x8 At[4][2], B0[2][2], B1[2][2];
    const char* cA = (const char*)g.A + (size_t)cur.pm * tstep; const char* cB = (const char*)g.Bt + (size_t)cur.pn * tstep;
    S.a_ready(cur);
    if constexpr (SP2) {
        PG8_STAGE(PG8_SB(0, 0), cB, voffB); PG8_STAGE(PG8_SB(0, 1), cB + hstep, voffB); PG8_STAGE(PG8_SA(0, 0), cA, voffA); PG8_STAGE(PG8_SA(0, 1), cA + hstep, voffA);
        if (wr == 1) PG8_BAR;
        PG8_WAIT_V(2); PG8_BAR;
        PG8_STAGE(PG8_SB(1, 0), cB + kstep, voffB); PG8_STAGE(PG8_SA(1, 0), cA + kstep, voffA); PG8_STAGE(PG8_SB(1, 1), cB + hstep + kstep, voffB);
        PG8_WAIT_V(6); PG8_BAR;
    } else {
        PG8_STAGE(PG8_SB(0, 0), cB, voffB); PG8_STAGE(PG8_SA(0, 0), cA, voffA); PG8_STAGE(PG8_SB(0, 1), cB + hstep, voffB); PG8_STAGE(PG8_SA(0, 1), cA + hstep, voffA);
        if (wr == 1) PG8_BAR;
        PG8_WAIT_V(4); PG8_BAR;
        PG8_STAGE(PG8_SB(1, 0), cB + kstep, voffB); PG8_STAGE(PG8_SA(1, 0), cA + kstep, voffA); PG8_STAGE(PG8_SB(1, 1), cB + hstep + kstep, voffB);
        PG8_WAIT_V(6); PG8_BAR;
    }
    for (;;) {
        const bool has_next = S.next(ui + 1, nxt);
        const char* nA = has_next ? (const char*)g.A + (size_t)nxt.pm * tstep : cA; const char* nB = has_next ? (const char*)g.Bt + (size_t)nxt.pn * tstep : cB;
        for (int t = 0; t < nt; t += 2) {
            const bool last = (t == nt - 2);
            const char* a1 = cA + (size_t)(t + 1) * kstep;
            const char* a2 = last ? nA : cA + (size_t)(t + 2) * kstep; const char* b2 = last ? nB : cB + (size_t)(t + 2) * kstep;
            const char* a3 = a2 + kstep; const char* b3 = b2 + kstep;
            if (last && has_next) S.a_ready(nxt);
            if constexpr (SP2) {
            PG8_LDB(B0, 0, 0); PG8_LDB(B1, 0, 1); PG8_SCHED; PG8_LDA(At, 0, 0); PG8_STAGE(PG8_SA(1, 1), a1 + hstep, voffA);
            PG8_WAIT_V(8); PG8_WAIT_L(0); PG8_BAR; PG8_MMA(0, 0, At, B0); PG8_MMA(0, 1, At, B1); PG8_BAR; PG8_SCHED;
            PG8_LDA(At, 0, 1); PG8_STAGE(PG8_SB(0, 0), b2, voffB); PG8_STAGE(PG8_SB(0, 1), b2 + hstep, voffB); PG8_STAGE(PG8_SA(0, 0), a2, voffA);
            PG8_WAIT_V(8); PG8_WAIT_L(0); PG8_BAR; PG8_MMA(1, 0, At, B0); PG8_MMA(1, 1, At, B1); PG8_BAR; PG8_SCHED;
            PG8_LDB(B0, 1, 0); PG8_LDB(B1, 1, 1); PG8_SCHED; PG8_LDA(At, 1, 0); PG8_STAGE(PG8_SA(0, 1), a2 + hstep, voffA);
            PG8_WAIT_V(8); PG8_WAIT_L(0); PG8_BAR; PG8_MMA(0, 0, At, B0); PG8_MMA(0, 1, At, B1); PG8_BAR; PG8_SCHED;
            PG8_LDA(At, 1, 1); PG8_STAGE(PG8_SB(1, 0), b3, voffB); PG8_STAGE(PG8_SB(1, 1), b3 + hstep, voffB); PG8_STAGE(PG8_SA(1, 0), a3, voffA);
            PG8_WAIT_V(8); PG8_WAIT_L(0); PG8_BAR; PG8_MMA(1, 0, At, B0); PG8_MMA(1, 1, At, B1); PG8_BAR; PG8_SCHED;
            } else {
            PG8_LDB(B0, 0, 0); PG8_SCHED; PG8_LDA(At, 0, 0); PG8_STAGE(PG8_SA(1, 1), a1 + hstep, voffA);
            PG8_WAIT_L(8); PG8_BAR; PG8_WAIT_L(0); PG8_MMA(0, 0, At, B0); PG8_BAR; PG8_SCHED;
            PG8_LDB(B1, 0, 1); PG8_STAGE(PG8_SB(0, 0), b2, voffB);
            PG8_BAR; PG8_WAIT_L(0); PG8_MMA(0, 1, At, B1); PG8_BAR;
            PG8_LDA(At, 0, 1); PG8_STAGE(PG8_SA(0, 0), a2, voffA);
            PG8_BAR; PG8_WAIT_L(0); PG8_MMA(1, 0, At, B0); PG8_BAR; PG8_SCHED;
            PG8_STAGE(PG8_SB(0, 1), b2 + hstep, voffB);
            PG8_WAIT_V(6); PG8_BAR; PG8_MMA(1, 1, At, B1); PG8_BAR;
            PG8_LDB(B0, 1, 0); PG8_SCHED; PG8_LDA(At, 1, 0); PG8_STAGE(PG8_SA(0, 1), a2 + hstep, voffA);
            PG8_WAIT_L(8); PG8_BAR; PG8_WAIT_L(0); PG8_MMA(0, 0, At, B0); PG8_BAR; PG8_SCHED;
            PG8_LDB(B1, 1, 1); PG8_STAGE(PG8_SB(1, 0), b3, voffB);
            PG8_BAR; PG8_WAIT_L(0); PG8_MMA(0, 1, At, B1); PG8_BAR;
            PG8_LDA(At, 1, 1); PG8_STAGE(PG8_SA(1, 0), a3, voffA);
            PG8_BAR; PG8_WAIT_L(0); PG8_MMA(1, 0, At, B0); PG8_BAR; PG8_SCHED;
            PG8_STAGE(PG8_SB(1, 1), b3 + hstep, voffB);
            PG8_WAIT_V(6); PG8_BAR; PG8_MMA(1, 1, At, B1); PG8_BAR;
            }
        }
        if constexpr (ALIGN_EPI) { if (wr == 0) PG8_BAR; }
        if constexpr (!Epi::AFTER_DRAIN) { E(acc, cur, wr, wc, fr, fq); S.done(cur); }
        if (!has_next) break;
#pragma unroll
        for (int a = 0; a < 2; ++a)
#pragma unroll
            for (int b = 0; b < 2; ++b)
#pragma unroll
                for (int m = 0; m < 4; ++m)
#pragma unroll
                    for (int n = 0; n < 2; ++n) acc[a][b][m][n] = (f32x4){0.f, 0.f, 0.f, 0.f};
        cur = nxt; cA = nA; cB = nB; ++ui;
        if constexpr (ALIGN_EPI) { if (wr == 1) PG8_BAR; }
    }
    PG8_WAIT_V(0);
    if constexpr (!ALIGN_EPI) { if (wr == 0) PG8_BAR; }
    PG8_BAR;
    if constexpr (Epi::AFTER_DRAIN) { E.fused(acc, cur, wr, wc, fr, fq, lds, wid, lane); S.done(cur); }
#undef PG8_SA
#undef PG8_SB
#undef PG8_STAGE
#undef PG8_LDA
#undef PG8_LDB
#undef PG8_MMA
#undef PG8_WAIT_V
#undef PG8_WAIT_L
#undef PG8_BAR
#undef PG8_SCHED
}
}

constexpr int NWAVES = 8;
constexpr int BATCH = 8, SEQ = 2048, DM = 1024, M = BATCH * SEQ, DEPTH = 2;
constexpr int D_IN = 3080, NPROJ = 3072, DFF = 2816, NUP = 5632, NUPH = 2816;
constexpr float EPS = 1e-6f;
constexpr int PC_QM = 0, PC_KM = 512, PC_VM = 1024, PC_OM = 1536, PC_QSB = 2048, PC_KSB = 2304, PC_VSB = 2560, PC_UP = 2816;

constexpr size_t MiB = 1u << 20;
constexpr size_t WS_CTL = 0, CTL_ZERO_BYTES = 1 * MiB;
constexpr size_t WS_WIN = 1 * MiB, WS_WOUT = 7 * MiB, WS_WUP = 9 * MiB, WS_WDN = 20 * MiB;
constexpr size_t WS_XN = 26 * MiB;
constexpr size_t WS_GATES = 58 * MiB, WS_SSQ = 58 * MiB + 512 * 1024;
constexpr size_t WS_PROJ = 60 * MiB;
constexpr size_t WS_QKC = 156 * MiB;
constexpr size_t WS_MIX = 188 * MiB;
constexpr size_t WS_Y = 60 * MiB;
constexpr size_t WS_UP = 60 * MiB;
constexpr size_t WS_ACT = 148 * MiB;
constexpr size_t WS_END = 236 * MiB;
constexpr int CW_TMO = 0, CW_CODE = 1, CW_BAR = 4096;

constexpr int RING_OFF = 0, RING_BYTES = 131072;
constexpr int LDSCTL_OFF = RING_BYTES, MISC_OFF = LDSCTL_OFF + 320;
constexpr int LDS_BYTES = 163840;


#define GAS __attribute__((address_space(1)))
#define LAS __attribute__((address_space(3)))
typedef unsigned short bf16;
typedef unsigned v4u __attribute__((ext_vector_type(4)));
typedef float f32x4 __attribute__((ext_vector_type(4)));
typedef short bf16x8 __attribute__((ext_vector_type(8)));
typedef GAS unsigned gu32;
typedef GAS unsigned long long gu64;
#define RLX_AGENT __ATOMIC_RELAXED, __HIP_MEMORY_SCOPE_AGENT
#define LDS_WAIT() asm volatile("s_waitcnt lgkmcnt(0)" ::: "memory")
#define VM_WAIT() asm volatile("s_waitcnt vmcnt(0)" ::: "memory")
__device__ __forceinline__ unsigned long long rt() { return __builtin_amdgcn_s_memrealtime(); }
__device__ __forceinline__ unsigned f2bf(float f) { unsigned u = __builtin_bit_cast(unsigned, f); return (u + 0x7fffu + ((u >> 16) & 1u)) >> 16; }
__device__ __forceinline__ unsigned pk2(float lo, float hi) { return f2bf(lo) | (f2bf(hi) << 16); }

#define XB_TMO      128
#define XB_XCNT(j)  (256  + 64 * (j))
#define XB_XSUB(j)  (1280 + 64 * (j))
#define XB_XGEN(j)  (2304 + 64 * (j))
#define XB_TOP      3328
#define XB_TOPGEN   3392
#define XCD_BAR_WORDS 3456
#define XB_SPIN_CAP (1u << 18)

__device__ __forceinline__ unsigned xb_ld(unsigned* p)              { return __hip_atomic_load(p, __ATOMIC_RELAXED, __HIP_MEMORY_SCOPE_AGENT); }
__device__ __forceinline__ unsigned xb_add(unsigned* p, unsigned v) { return __hip_atomic_fetch_add(p, v, __ATOMIC_RELAXED, __HIP_MEMORY_SCOPE_AGENT); }
__device__ __forceinline__ unsigned xb_xcc_id() { return (unsigned)__builtin_amdgcn_s_getreg((3 << 11) | 20) & 0xFu; }
#define XB_SPIN(cond, bar) do { unsigned _sp = 0; while (cond) { __builtin_amdgcn_s_sleep(1); \
    if ((++_sp & 255u) == 0u) { if (xb_ld(&(bar)[XB_TMO])) break; if (_sp > XB_SPIN_CAP) { atomicAdd(&(bar)[XB_TMO], 1u); break; } } } } while (0)

struct XcdBarrier {
    unsigned* bar; unsigned x;
    volatile LAS unsigned* st;
};

__device__ __forceinline__ XcdBarrier xcd_barrier_post(unsigned* bar, volatile LAS unsigned* st) {
    XcdBarrier b; b.bar = bar; b.x = xb_xcc_id(); b.st = st;
    if (threadIdx.x == 0) (void)xb_add(&bar[XB_XCNT(b.x)], 1u);
    return b;
}
__device__ __forceinline__ void xcd_barrier_complete(unsigned* bar, unsigned x, unsigned& nloc, unsigned& nx) {
    const unsigned G = gridDim.x * gridDim.y * gridDim.z;
    unsigned sum, cnt, mine, sp = 0u;
    for (;;) {
        sum = 0u; cnt = 0u; mine = 0u;
#pragma unroll
        for (unsigned j = 0; j < 16; ++j) { const unsigned c = xb_ld(&bar[XB_XCNT(j)]); sum += c; cnt += (c > 0u) ? 1u : 0u; mine = (j == x) ? c : mine; }
        if (sum == G) break;
        __builtin_amdgcn_s_sleep(1);
        if ((++sp & 255u) == 0u) { if (xb_ld(&bar[XB_TMO])) break; if (sp > XB_SPIN_CAP) { atomicAdd(&bar[XB_TMO], 1u); break; } }
    }
    nloc = mine > 0u ? mine : 1u; nx = cnt > 0u ? cnt : 1u;
}

__device__ __forceinline__ void xcd_barrier(const XcdBarrier& b) {
    asm volatile("s_waitcnt vmcnt(0)" ::: "memory");
    __syncthreads();
    if (threadIdx.x == 0) {
        unsigned* bar = b.bar;
        __builtin_amdgcn_s_waitcnt(0);
        unsigned nloc = b.st[0], nx = b.st[1];
        if (nloc == 0u) { xcd_barrier_complete(bar, b.x, nloc, nx); b.st[0] = nloc; b.st[1] = nx; }
        const unsigned old = xb_add(&bar[XB_XSUB(b.x)], 1u);
        const unsigned gen = old / nloc;
        if (old + 1u == (gen + 1u) * nloc) {
            __builtin_amdgcn_fence(__ATOMIC_RELEASE, "agent");
            asm volatile("s_waitcnt vmcnt(0)" ::: "memory");
            const unsigned og = xb_add(&bar[XB_TOP], 1u);
            const unsigned tg = og / nx;
            if (og + 1u == (tg + 1u) * nx) xb_add(&bar[XB_TOPGEN], 1u);
            else XB_SPIN(xb_ld(&bar[XB_TOPGEN]) == tg, bar);
            __builtin_amdgcn_fence(__ATOMIC_ACQUIRE, "agent");
            xb_add(&bar[XB_XGEN(b.x)], 1u);
            asm volatile("s_waitcnt vmcnt(0)" ::: "memory");
        } else {
            XB_SPIN(xb_ld(&bar[XB_XGEN(b.x)]) == gen, bar);
            __builtin_amdgcn_fence(__ATOMIC_ACQUIRE, "agent");
            asm volatile("s_waitcnt vmcnt(0)" ::: "memory");
        }
    }
    __syncthreads();
}

typedef unsigned v2u __attribute__((ext_vector_type(2)));
struct Frame {
    LAS unsigned char* lds;
    volatile LAS unsigned* MISC;
    gu32* ctl;
    int tid, lane, wave;
    int vcu, G;
    float* out;
    unsigned char* ws;
};
__device__ __forceinline__ const float* inp(const Frame& F, int i) {
    const volatile LAS unsigned* t = (const volatile LAS unsigned*)(F.lds + LDSCTL_OFF) + 2 * i;
    const unsigned lo = __builtin_amdgcn_readfirstlane(t[0]), hi = __builtin_amdgcn_readfirstlane(t[1]);
    return (const float*)(((unsigned long long)hi << 32) | lo);
}
__device__ __forceinline__ float bflo(unsigned w) { return __uint_as_float(w << 16); }
__device__ __forceinline__ float bfhi(unsigned w) { return __uint_as_float(w & 0xffff0000u); }
__device__ __forceinline__ float bf2f(bf16 u) { return __uint_as_float((unsigned)u << 16); }
__device__ __forceinline__ float wave_sum(float v) {
#pragma unroll
    for (int o = 1; o < 64; o <<= 1) v += __shfl_xor(v, o);
    return v;
}
__device__ __forceinline__ float sigmoidf_(float x) { return 1.0f / (1.0f + __expf(-x)); }
__device__ __forceinline__ float logsigf_(float x) { return fminf(x, 0.f) - log1pf(__expf(-fabsf(x))); }

__device__ __forceinline__ void transpose_item(const float* W, int ldw, int K, bf16* WT, int n0, int c0, int k0, const float* ks, LAS float* scr, int lane) {
#pragma unroll 8
    for (int i = 0; i < 32; ++i) { const int kk = 2 * i + (lane >> 5); float v = W[(size_t)(k0 + kk) * ldw + c0 + (lane & 31)]; if (ks) v *= ks[k0 + kk]; scr[kk * 33 + (lane & 31)] = v; }
    LDS_WAIT(); asm volatile("" ::: "memory");
    const int c = lane & 7;
#pragma unroll
    for (int j = 0; j < 4; ++j) { const int n = (lane >> 3) + 8 * j; const LAS float* s = scr + (8 * c) * 33 + n;
        v4u o; o.x = pk2(s[0 * 33], s[1 * 33]); o.y = pk2(s[2 * 33], s[3 * 33]); o.z = pk2(s[4 * 33], s[5 * 33]); o.w = pk2(s[6 * 33], s[7 * 33]);
        *(GAS v4u*)(WT + (size_t)(n0 + n) * K + k0 + 8 * c) = o; }
    LDS_WAIT(); asm volatile("" ::: "memory");
}
__device__ __forceinline__ void convert_weights(Frame& F, int l) {
    LAS float* scr = (LAS float*)(F.lds + RING_OFF + F.wave * 16384);
    const int gw = F.vcu * NWAVES + F.wave, NGW = F.G * NWAVES;
    const float* w_in = inp(F, 2) + (size_t)l * DM * D_IN;
    const float* w_out = inp(F, 12) + (size_t)l * DM * DM;
    const float* w_up = inp(F, 15) + (size_t)l * DM * NUP;
    const float* w_dn = inp(F, 18) + (size_t)l * DFF * DM;
    bf16* Win_t = (bf16*)(F.ws + WS_WIN); bf16* Wout_t = (bf16*)(F.ws + WS_WOUT); bf16* Wup_t = (bf16*)(F.ws + WS_WUP); bf16* Wdn_t = (bf16*)(F.ws + WS_WDN);
    constexpr int I_IN = 16 * 96, I_OUT = 16 * 32, I_UP = 16 * 176, I_DN = 44 * 32;
    for (int it = gw; it < I_IN + I_OUT + I_UP + I_DN; it += NGW) {
        int r = it;
        if (r < I_IN) { const int kb = r / 96, nb = r % 96, n0 = 32 * nb; transpose_item(w_in, D_IN, DM, Win_t, n0, n0 < 2048 ? n0 : n0 + 8, 64 * kb, nullptr, scr, F.lane); continue; } r -= I_IN;
        if (r < I_OUT) { const int kb = r / 32, nb = r % 32, k0 = 64 * kb;
            const float* ks = k0 < 512 ? inp(F, 9) + l * 512 - 0 : (k0 < 768 ? inp(F, 10) + l * 256 - 512 : inp(F, 11) + l * 256 - 768);
            transpose_item(w_out, DM, DM, Wout_t, 32 * nb, 32 * nb, k0, ks, scr, F.lane); continue; } r -= I_OUT;
        if (r < I_UP) { const int kb = r / 176, nb = r % 176, n0 = 32 * nb, j = n0 >> 8, i = n0 & 255; const int c0 = i < 128 ? 128 * j + i : DFF + 128 * j + (i - 128);
            transpose_item(w_up, NUP, DM, Wup_t, n0, c0, 64 * kb, nullptr, scr, F.lane); continue; } r -= I_UP;
        { const int kb = r / 32, nb = r % 32; transpose_item(w_dn, DM, DFF, Wdn_t, 32 * nb, 32 * nb, 64 * kb, nullptr, scr, F.lane); }
    }
}
__device__ __forceinline__ void row_norm_store(Frame& F, const f32x4 (&v)[4], const float* g, int l, int m, bool with_gates) {
    float ss = 0.f;
#pragma unroll
    for (int j = 0; j < 4; ++j) ss += (v[j].x * v[j].x + v[j].y * v[j].y) + (v[j].z * v[j].z + v[j].w * v[j].w);
    const float rstd = 1.0f / sqrtf(wave_sum(ss) * (1.0f / DM) + EPS);
    f32x4 h[4];
    bf16* xn = (bf16*)(F.ws + WS_XN) + (size_t)m * DM;
#pragma unroll
    for (int j = 0; j < 4; ++j) { const f32x4 gg = *(const f32x4*)(g + 4 * F.lane + 256 * j); h[j] = v[j] * rstd * gg;
        v2u o; o.x = pk2(h[j].x, h[j].y); o.y = pk2(h[j].z, h[j].w); *(GAS v2u*)(xn + 4 * F.lane + 256 * j) = o; }
    if (with_gates) {
        const float* wg = inp(F, 2) + (size_t)l * DM * D_IN + 2048;
        float a[8];
#pragma unroll
        for (int e = 0; e < 8; ++e) a[e] = 0.f;
#pragma unroll
        for (int j = 0; j < 4; ++j)
#pragma unroll
            for (int e = 0; e < 4; ++e) { const int k = 4 * F.lane + 256 * j + e; const f32x4 w0 = *(const f32x4*)(wg + (size_t)k * D_IN), w1 = *(const f32x4*)(wg + (size_t)k * D_IN + 4); const float hv = h[j][e];
                a[0] += hv * w0.x; a[1] += hv * w0.y; a[2] += hv * w0.z; a[3] += hv * w0.w; a[4] += hv * w1.x; a[5] += hv * w1.y; a[6] += hv * w1.z; a[7] += hv * w1.w; }
#pragma unroll
        for (int e = 0; e < 8; ++e) a[e] = wave_sum(a[e]);
        float* gt = (float*)(F.ws + WS_GATES) + (size_t)m * 8;
        if (F.lane == 0) {
#pragma unroll
            for (int e = 0; e < 4; ++e) { gt[e] = a[e] + inp(F, 5)[l * 4 + e]; gt[4 + e] = logsigf_(a[4 + e] + inp(F, 6)[l * 4 + e]); }
        }
    }
}
__device__ __forceinline__ void p_prologue(Frame& F) {
    convert_weights(F, 0);
    const int gw = F.vcu * NWAVES + F.wave, NGW = F.G * NWAVES;
    for (int m = gw; m < M; m += NGW) {
        const GAS f32x4* xr = (const GAS f32x4*)(inp(F, 0) + (size_t)m * DM) + F.lane; f32x4 v[4];
#pragma unroll
        for (int j = 0; j < 4; ++j) v[j] = xr[64 * j];
        row_norm_store(F, v, inp(F, 1), 0, m, true);
    }
}
__device__ __forceinline__ void p_conv_pool(Frame& F, int l) {
    const bf16* PROJ = (const bf16*)(F.ws + WS_PROJ); bf16* QKC = (bf16*)(F.ws + WS_QKC); bf16* MIX = (bf16*)(F.ws + WS_MIX);
    const float* cw = inp(F, 3) + (size_t)l * 4 * 1024; const float* cb = inp(F, 4) + (size_t)l * 1024;
    const int gt = F.vcu * (NWAVES * 64) + F.tid, NGT = F.G * NWAVES * 64;
    for (int it = gt; it < M * 128; it += NGT) {
        const int m = it >> 7, c = (it & 127) * 8, s = m & (SEQ - 1);
        float a[8];
#pragma unroll
        for (int e = 0; e < 8; ++e) a[e] = cb[c + e];
#pragma unroll
        for (int j = 0; j < 4; ++j) { if (s - 3 + j >= 0) { const v4u p = *(const GAS v4u*)(PROJ + (size_t)(m - 3 + j) * NPROJ + c); const float* w = cw + j * 1024 + c;
            a[0] += w[0] * bflo(p.x); a[1] += w[1] * bfhi(p.x); a[2] += w[2] * bflo(p.y); a[3] += w[3] * bfhi(p.y); a[4] += w[4] * bflo(p.z); a[5] += w[5] * bfhi(p.z); a[6] += w[6] * bflo(p.w); a[7] += w[7] * bfhi(p.w); } }
        const float sc = c >= 512 ? 0.08838834764831845f : 1.0f;
#pragma unroll
        for (int e = 0; e < 8; ++e) a[e] = a[e] * sigmoidf_(a[e]) * sc;
        v4u o; o.x = pk2(a[0], a[1]); o.y = pk2(a[2], a[3]); o.z = pk2(a[4], a[5]); o.w = pk2(a[6], a[7]);
        *(GAS v4u*)(QKC + (size_t)m * 1024 + c) = o;
    }
    const float* pw = inp(F, 7) + (size_t)l * 4 * 64 * 64; const float* psc = inp(F, 8) + (size_t)l * 256;
    LAS float* pl = (LAS float*)(F.lds + RING_OFF + F.wave * 1024);
    const int gw = F.vcu * NWAVES + F.wave, NGW = F.G * NWAVES;
    const int g = F.lane >> 4, win = 2 << g;
    for (int m = gw; m < M; m += NGW) {
        const int s = m & (SEQ - 1); const int cnt = (s + 1) < win ? (s + 1) : win;
        float sum[4] = {0.f, 0.f, 0.f, 0.f}, u0[4];
        for (int j = 0; j < cnt; ++j) { const v2u p = *(const GAS v2u*)(PROJ + (size_t)(m - j) * NPROJ + PC_UP + 4 * F.lane); const float x0 = bflo(p.x), x1 = bfhi(p.x), x2 = bflo(p.y), x3 = bfhi(p.y);
            if (j == 0) { u0[0] = x0; u0[1] = x1; u0[2] = x2; u0[3] = x3; } sum[0] += x0; sum[1] += x1; sum[2] += x2; sum[3] += x3; }
        const float ic = 1.0f / (float)cnt;
#pragma unroll
        for (int e = 0; e < 4; ++e) pl[4 * F.lane + e] = sum[e] * ic - u0[e];
        LDS_WAIT(); asm volatile("" ::: "memory");
        f32x4 y = (f32x4){0.f, 0.f, 0.f, 0.f}; const int e4 = (F.lane & 15) * 4;
        for (int c = 0; c < 64; ++c) { const float p = pl[g * 64 + c]; const f32x4 w = *(const f32x4*)(pw + (size_t)(g * 64 + c) * 64 + e4); y += w * p; }
        const f32x4 ps = *(const f32x4*)(psc + 4 * F.lane); y = y * ps;
        const float ssq = wave_sum((y.x * y.x + y.y * y.y) + (y.z * y.z + y.w * y.w));
        const float rstd = 1.0f / sqrtf(ssq * (1.0f / 256.0f) + EPS);
        v2u o; o.x = pk2(y.x * rstd, y.y * rstd); o.y = pk2(y.z * rstd, y.w * rstd);
        *(GAS v2u*)(MIX + (size_t)m * 1024 + 768 + 4 * F.lane) = o;
        LDS_WAIT(); asm volatile("" ::: "memory");
    }
}

__device__ __forceinline__ void mlstm_unit_scalar(Frame& F, int b, int h, int qb) {
    LAS unsigned char* L = F.lds + RING_OFF;
    LAS float* Qs = (LAS float*)L;
    LAS bf16* Ks = (LAS bf16*)(L + 33792);
    LAS bf16* Vs = (LAS bf16*)(L + 33792 + 17408);
    LAS float* Ps = (LAS float*)(L + 33792 + 2 * 17408);
    LAS float* Cs = (LAS float*)(L + 33792 + 3 * 17408);
    LAS float* Rr = Cs + 2048;
    LAS float* Mr = Rr + 64;
    LAS float* Wt = Mr + 64;
    const bf16* PROJ = (const bf16*)(F.ws + WS_PROJ); const bf16* QKC = (const bf16*)(F.ws + WS_QKC); bf16* MIX = (bf16*)(F.ws + WS_MIX);
    const float* GT = (const float*)(F.ws + WS_GATES); float* SSQ = (float*)(F.ws + WS_SSQ);
    const int tid = F.tid, row = tid >> 3, sub = tid & 7, lane = F.lane, wave = F.wave;
    const int t0 = b * SEQ, q0 = qb * 64, n = q0 + 64;
    __syncthreads();
    {
        float lf[4], ig[4];
#pragma unroll
        for (int e = 0; e < 4; ++e) { const int idx = 4 * tid + e; if (idx < n) { lf[e] = GT[(size_t)(t0 + idx) * 8 + 4 + h]; ig[e] = GT[(size_t)(t0 + idx) * 8 + h]; } else { lf[e] = 0.f; ig[e] = -INFINITY; } }
        float cB[4]; cB[0] = lf[0]; cB[1] = cB[0] + lf[1]; cB[2] = cB[1] + lf[2]; cB[3] = cB[2] + lf[3];
        const float tot = cB[3]; float inc = tot;
#pragma unroll
        for (int o = 1; o < 64; o <<= 1) { const float t = __shfl_up(inc, o); if (lane >= o) inc += t; }
        if (lane == 63) Wt[wave] = inc;
        __syncthreads();
        float pre = inc - tot;
        for (int w = 0; w < wave; ++w) pre += Wt[w];
        float cc[4], cm[4];
#pragma unroll
        for (int e = 0; e < 4; ++e) { cB[e] += pre; cc[e] = ig[e] - cB[e]; }
        cm[0] = cc[0]; cm[1] = fmaxf(cm[0], cc[1]); cm[2] = fmaxf(cm[1], cc[2]); cm[3] = fmaxf(cm[2], cc[3]);
        float minc = cm[3];
#pragma unroll
        for (int o = 1; o < 64; o <<= 1) { const float t = __shfl_up(minc, o); if (lane >= o) minc = fmaxf(minc, t); }
        __syncthreads();
        if (lane == 63) Wt[wave] = minc;
        __syncthreads();
        float mpre = __shfl_up(minc, 1); if (lane == 0) mpre = -INFINITY;
        for (int w = 0; w < wave; ++w) mpre = fmaxf(mpre, Wt[w]);
#pragma unroll
        for (int e = 0; e < 4; ++e) { const int idx = 4 * tid + e; if (idx < n) { const float cmx = fmaxf(mpre, cm[e]); const float mt = cB[e] + fmaxf(0.f, cmx); Cs[idx] = cc[e];
            if (idx >= q0) { Rr[idx - q0] = cB[e] - mt; Mr[idx - q0] = mt; } } }
    }
#pragma unroll
    for (int i = 0; i < 2; ++i) { const int ch = tid + 512 * i, r = ch >> 4, c = (ch & 15) * 8; const v4u p = *(const GAS v4u*)(QKC + (size_t)(t0 + q0 + r) * 1024 + h * 128 + c);
        LAS float* d = Qs + r * 132 + c; d[0] = bflo(p.x); d[1] = bfhi(p.x); d[2] = bflo(p.y); d[3] = bfhi(p.y); d[4] = bflo(p.z); d[5] = bfhi(p.z); d[6] = bflo(p.w); d[7] = bfhi(p.w); }
    float acc[16]; float den = 0.f;
#pragma unroll
    for (int e = 0; e < 16; ++e) acc[e] = 0.f;
    for (int kt = 0; kt <= qb; ++kt) {
        __syncthreads();
#pragma unroll
        for (int i = 0; i < 2; ++i) { const int ch = tid + 512 * i, r = ch >> 4, c = (ch & 15) * 8;
            *(LAS v4u*)(Ks + r * 136 + c) = *(const GAS v4u*)(QKC + (size_t)(t0 + kt * 64 + r) * 1024 + 512 + h * 128 + c);
            *(LAS v4u*)(Vs + r * 136 + c) = *(const GAS v4u*)(PROJ + (size_t)(t0 + kt * 64 + r) * NPROJ + PC_VM + h * 128 + c); }
        __syncthreads();
        float s[8];
#pragma unroll
        for (int i = 0; i < 8; ++i) s[i] = 0.f;
        for (int d = 0; d < 128; d += 4) { const f32x4 q = *(const LAS f32x4*)(Qs + row * 132 + d);
#pragma unroll
            for (int i = 0; i < 8; ++i) { const v2u k = *(const LAS v2u*)(Ks + (sub * 8 + i) * 136 + d); s[i] += q.x * bflo(k.x) + q.y * bfhi(k.x) + q.z * bflo(k.y) + q.w * bfhi(k.y); } }
        const float rr = Rr[row];
#pragma unroll
        for (int i = 0; i < 8; ++i) { const int key = sub * 8 + i; const float w = (kt * 64 + key <= q0 + row) ? s[i] * __expf(rr + Cs[kt * 64 + key]) : 0.f; den += w; Ps[row * 68 + key] = w; }
        __syncthreads();
        for (int key = 0; key < 64; ++key) { const float p = Ps[row * 68 + key]; const v4u v0 = *(const LAS v4u*)(Vs + key * 136 + sub * 16), v1 = *(const LAS v4u*)(Vs + key * 136 + sub * 16 + 8);
            acc[0] += p * bflo(v0.x); acc[1] += p * bfhi(v0.x); acc[2] += p * bflo(v0.y); acc[3] += p * bfhi(v0.y); acc[4] += p * bflo(v0.z); acc[5] += p * bfhi(v0.z); acc[6] += p * bflo(v0.w); acc[7] += p * bfhi(v0.w);
            acc[8] += p * bflo(v1.x); acc[9] += p * bfhi(v1.x); acc[10] += p * bflo(v1.y); acc[11] += p * bfhi(v1.y); acc[12] += p * bflo(v1.z); acc[13] += p * bfhi(v1.z); acc[14] += p * bflo(v1.w); acc[15] += p * bfhi(v1.w); }
    }
    den += __shfl_xor(den, 1); den += __shfl_xor(den, 2); den += __shfl_xor(den, 4);
    const float scl = 1.0f / fmaxf(fabsf(den), __expf(-Mr[row]));
    const int m = t0 + q0 + row;
    const v4u g0 = *(const GAS v4u*)(PROJ + (size_t)m * NPROJ + PC_OM + h * 128 + sub * 16), g1 = *(const GAS v4u*)(PROJ + (size_t)m * NPROJ + PC_OM + h * 128 + sub * 16 + 8);
    float og[16] = {bflo(g0.x), bfhi(g0.x), bflo(g0.y), bfhi(g0.y), bflo(g0.z), bfhi(g0.z), bflo(g0.w), bfhi(g0.w), bflo(g1.x), bfhi(g1.x), bflo(g1.y), bfhi(g1.y), bflo(g1.z), bfhi(g1.z), bflo(g1.w), bfhi(g1.w)};
    float ssq = 0.f;
#pragma unroll
    for (int e = 0; e < 16; ++e) { acc[e] = acc[e] * scl * sigmoidf_(og[e]); ssq += acc[e] * acc[e]; }
    v4u o0, o1; o0.x = pk2(acc[0], acc[1]); o0.y = pk2(acc[2], acc[3]); o0.z = pk2(acc[4], acc[5]); o0.w = pk2(acc[6], acc[7]); o1.x = pk2(acc[8], acc[9]); o1.y = pk2(acc[10], acc[11]); o1.z = pk2(acc[12], acc[13]); o1.w = pk2(acc[14], acc[15]);
    *(GAS v4u*)(MIX + (size_t)m * 1024 + h * 128 + sub * 16) = o0; *(GAS v4u*)(MIX + (size_t)m * 1024 + h * 128 + sub * 16 + 8) = o1;
    ssq += __shfl_xor(ssq, 1); ssq += __shfl_xor(ssq, 2); ssq += __shfl_xor(ssq, 4);
    if (sub == 0) SSQ[(size_t)m * 8 + h] = ssq;
}
__device__ __forceinline__ void sb_unit_scalar(Frame& F, int b, int h, int qb) {
    LAS unsigned char* L = F.lds + RING_OFF;
    LAS float* Qs = (LAS float*)L;
    LAS bf16* Ks = (LAS bf16*)(L + 17408);
    LAS bf16* Vs = (LAS bf16*)(L + 17408 + 9216);
    LAS float* Ps = (LAS float*)(L + 17408 + 2 * 9216);
    const bf16* PROJ = (const bf16*)(F.ws + WS_PROJ); bf16* MIX = (bf16*)(F.ws + WS_MIX); float* SSQ = (float*)(F.ws + WS_SSQ);
    const int tid = F.tid, row = tid >> 3, sub = tid & 7;
    const int t0 = b * SEQ, q0 = qb * 64;
    __syncthreads();
    { const int r = tid >> 3, c = (tid & 7) * 8; const v4u p = *(const GAS v4u*)(PROJ + (size_t)(t0 + q0 + r) * NPROJ + PC_QSB + h * 64 + c);
        LAS float* d = Qs + r * 68 + c; d[0] = 0.125f * bflo(p.x); d[1] = 0.125f * bfhi(p.x); d[2] = 0.125f * bflo(p.y); d[3] = 0.125f * bfhi(p.y); d[4] = 0.125f * bflo(p.z); d[5] = 0.125f * bfhi(p.z); d[6] = 0.125f * bflo(p.w); d[7] = 0.125f * bfhi(p.w); }
    float acc[8]; float run = 0.f;
#pragma unroll
    for (int e = 0; e < 8; ++e) acc[e] = 0.f;
    for (int kt = qb; kt >= 0; --kt) {
        __syncthreads();
        { const int r = tid >> 3, c = (tid & 7) * 8;
            *(LAS v4u*)(Ks + r * 72 + c) = *(const GAS v4u*)(PROJ + (size_t)(t0 + kt * 64 + r) * NPROJ + PC_KSB + h * 64 + c);
            *(LAS v4u*)(Vs + r * 72 + c) = *(const GAS v4u*)(PROJ + (size_t)(t0 + kt * 64 + r) * NPROJ + PC_VSB + h * 64 + c); }
        __syncthreads();
        float z[8];
#pragma unroll
        for (int i = 0; i < 8; ++i) z[i] = 0.f;
        for (int d = 0; d < 64; d += 4) { const f32x4 q = *(const LAS f32x4*)(Qs + row * 68 + d);
#pragma unroll
            for (int i = 0; i < 8; ++i) { const v2u k = *(const LAS v2u*)(Ks + (sub * 8 + i) * 72 + d); z[i] += q.x * bflo(k.x) + q.y * bfhi(k.x) + q.z * bflo(k.y) + q.w * bfhi(k.y); } }
        float Lk[8], lsz[8]; bool valid[8];
#pragma unroll
        for (int i = 0; i < 8; ++i) { valid[i] = (kt * 64 + sub * 8 + i) < (q0 + row); const float sp = fmaxf(z[i], 0.f) + log1pf(__expf(-fabsf(z[i]))); Lk[i] = valid[i] ? -sp : 0.f; lsz[i] = z[i] - sp; }
        float esfx[8]; esfx[7] = 0.f;
#pragma unroll
        for (int i = 6; i >= 0; --i) esfx[i] = esfx[i + 1] + Lk[i + 1];
        const float tot = esfx[0] + Lk[0]; float inc = tot;
#pragma unroll
        for (int o = 1; o < 8; o <<= 1) { const float t = __shfl_down(inc, o, 8); if (sub + o < 8) inc += t; }
        const float excl = inc - tot;
#pragma unroll
        for (int i = 0; i < 8; ++i) { const float a = valid[i] ? __expf(lsz[i] + run + excl + esfx[i]) : 0.f; Ps[row * 68 + sub * 8 + i] = a; }
        run += __shfl(inc, 0, 8);
        __syncthreads();
        for (int key = 0; key < 64; ++key) { const float p = Ps[row * 68 + key]; const v4u v0 = *(const LAS v4u*)(Vs + key * 72 + sub * 8);
            acc[0] += p * bflo(v0.x); acc[1] += p * bfhi(v0.x); acc[2] += p * bflo(v0.y); acc[3] += p * bfhi(v0.y); acc[4] += p * bflo(v0.z); acc[5] += p * bfhi(v0.z); acc[6] += p * bflo(v0.w); acc[7] += p * bfhi(v0.w); }
    }
    const int m = t0 + q0 + row;
    float ssq = 0.f;
#pragma unroll
    for (int e = 0; e < 8; ++e) ssq += acc[e] * acc[e];
    v4u o0; o0.x = pk2(acc[0], acc[1]); o0.y = pk2(acc[2], acc[3]); o0.z = pk2(acc[4], acc[5]); o0.w = pk2(acc[6], acc[7]);
    *(GAS v4u*)(MIX + (size_t)m * 1024 + 512 + h * 64 + sub * 8) = o0;
    ssq += __shfl_xor(ssq, 1); ssq += __shfl_xor(ssq, 2); ssq += __shfl_xor(ssq, 4);
    if (sub == 0) SSQ[(size_t)m * 8 + 4 + h] = ssq;
}

typedef float f32x16 __attribute__((ext_vector_type(16)));
typedef short s16x4 __attribute__((ext_vector_type(4)));
typedef short v4i16_t __attribute__((ext_vector_type(4)));
typedef float f32x2_t __attribute__((ext_vector_type(2))); typedef __bf16 bf16x2_t __attribute__((ext_vector_type(2)));
constexpr int SP_CS = 131584, SP_RM = 139776, SP_WT = 141824, SP_WSF = 141888, SP_FLAG = 143936;
constexpr float LOG2E = 1.4426950408889634f;
__device__ __forceinline__ int crow(int r, int hi) { return (r & 3) + 8 * (r >> 2) + 4 * hi; }
__device__ __forceinline__ unsigned cvtpk_s(float lo, float hi) { f32x2_t v = {lo, hi}; bf16x2_t b = __builtin_convertvector(v, bf16x2_t); return __builtin_bit_cast(unsigned, b); }
__device__ __forceinline__ s16x4 vtr(const LAS unsigned char* p) { return __builtin_bit_cast(s16x4, __builtin_amdgcn_ds_read_tr16_b64_v4i16((LAS v4i16_t*)p)); }
__device__ __forceinline__ void glds16(const void* g, LAS unsigned char* l) { __builtin_amdgcn_global_load_lds((const unsigned*)g, (LAS unsigned*)l, 16, 0, 0); }
#define MFMA32(a, b, c) __builtin_amdgcn_mfma_f32_32x32x16_bf16((a), (b), (c), 0, 0, 0)
#define VFRAG(lo, hh) (bf16x8){(lo)[0], (lo)[1], (lo)[2], (lo)[3], (hh)[0], (hh)[1], (hh)[2], (hh)[3]}

__device__ __forceinline__ void mlstm_dma(LAS unsigned char* buf, const bf16* QKC, const bf16* PROJ, int t0, int h, int kt, int w, int lane) {
    if (w < 4) { const int kh = w >> 1; const bf16* src = QKC + (size_t)(t0 + 128 * kt + 64 * kh + lane) * 1024 + 512 + 128 * h + 64 * (w & 1); LAS unsigned char* dst = buf + kh * 16384 + (w & 1) * 8192;
#pragma unroll
        for (int i = 0; i < 8; ++i) glds16(src + 8 * i, dst + i * 1024);
    } else { const int w4 = w - 4, kh = w4 >> 1;
#pragma unroll
        for (int i = 0; i < 8; ++i) { const int dq = (w4 & 1) * 2 + (i >> 2), rg = i & 3;
            const bf16* src = PROJ + (size_t)(t0 + 128 * kt + 64 * kh + 16 * rg + (lane >> 2)) * NPROJ + PC_VM + 128 * h + 32 * dq + 8 * (lane & 3);
            glds16(src, buf + 32768 + kh * 16384 + (dq * 4 + rg) * 1024); }
    }
}
__device__ __forceinline__ void mlstm_block(Frame& F, int b, int h, int jb, const LAS float* RMb) {
    const int lane = F.lane, w = F.wave, r32 = lane & 31, hi = lane >> 5, rg = w & 3, kh = w >> 2;
    LAS unsigned char* ring = F.lds + RING_OFF;
    const LAS float* Cs = (const LAS float*)(F.lds + SP_CS);
    LAS float* wsf = (LAS float*)(F.lds + SP_WSF) + w * 64;
    const bf16* PROJ = (const bf16*)(F.ws + WS_PROJ); const bf16* QKC = (const bf16*)(F.ws + WS_QKC); bf16* MIX = (bf16*)(F.ws + WS_MIX); float* SSQ = (float*)(F.ws + WS_SSQ);
    const int t0 = b * SEQ;
    bf16x8 qr[8];
    { const bf16* Qp = QKC + (size_t)(t0 + 128 * jb + 32 * rg + r32) * 1024 + 128 * h + 8 * hi;
#pragma unroll
      for (int d0 = 0; d0 < 8; ++d0) qr[d0] = *(const GAS bf16x8*)(Qp + 16 * d0); }
    const float rq = RMb[(32 * rg + r32) * 2], mq = RMb[(32 * rg + r32) * 2 + 1];
    f32x16 o[4]; float den = 0.f;
#pragma unroll
    for (int d0 = 0; d0 < 4; ++d0) o[d0] = (f32x16){0.f, 0.f, 0.f, 0.f, 0.f, 0.f, 0.f, 0.f, 0.f, 0.f, 0.f, 0.f, 0.f, 0.f, 0.f, 0.f};
    __syncthreads();
    mlstm_dma(ring, QKC, PROJ, t0, h, 0, w, lane);
    for (int kt = 0; kt <= jb; ++kt) {
        __syncthreads();
        if (kt < jb) mlstm_dma(ring + ((kt + 1) & 1) * 65536, QKC, PROJ, t0, h, kt + 1, w, lane);
        const bool diag = (kt == jb);
        if (diag && 64 * kh >= 32 * rg + 32) continue;
        const LAS unsigned char* Kb = ring + (kt & 1) * 65536 + kh * 16384;
        const LAS unsigned char* Vb = Kb + 32768;
        f32x16 p0 = (f32x16){0.f, 0.f, 0.f, 0.f, 0.f, 0.f, 0.f, 0.f, 0.f, 0.f, 0.f, 0.f, 0.f, 0.f, 0.f, 0.f}, p1 = p0;
        { const LAS unsigned char* kb = Kb + hi * 1024 + r32 * 16;
#pragma unroll
          for (int d0 = 0; d0 < 8; ++d0) { const bf16x8 b0 = *(const LAS bf16x8*)(kb + d0 * 2048), b1 = *(const LAS bf16x8*)(kb + d0 * 2048 + 512);
              p0 = MFMA32(b0, qr[d0], p0); p1 = MFMA32(b1, qr[d0], p1); } }
        { const LAS float* cp = Cs + 128 * kt + 64 * kh + 4 * hi;
#pragma unroll
          for (int g = 0; g < 4; ++g) { const f32x4 c0 = *(const LAS f32x4*)(cp + 8 * g), c1 = *(const LAS f32x4*)(cp + 32 + 8 * g);
#pragma unroll
              for (int i = 0; i < 4; ++i) { p0[4 * g + i] *= __builtin_amdgcn_exp2f(rq + c0[i]); p1[4 * g + i] *= __builtin_amdgcn_exp2f(rq + c1[i]); } } }
        if (diag) { const int lim = 32 * rg + r32 - 64 * kh - 4 * hi;
#pragma unroll
            for (int r = 0; r < 16; ++r) { const int kv = (r & 3) + 8 * (r >> 2); p0[r] = kv <= lim ? p0[r] : 0.f; p1[r] = kv + 32 <= lim ? p1[r] : 0.f; } }
#pragma unroll
        for (int r = 0; r < 16; ++r) den += p0[r] + p1[r];
        v4u pw0, pw1, pw2, pw3;
        pw0 = (v4u){cvtpk_s(p0[0], p0[1]), cvtpk_s(p0[2], p0[3]), cvtpk_s(p0[4], p0[5]), cvtpk_s(p0[6], p0[7])};
        pw1 = (v4u){cvtpk_s(p0[8], p0[9]), cvtpk_s(p0[10], p0[11]), cvtpk_s(p0[12], p0[13]), cvtpk_s(p0[14], p0[15])};
        pw2 = (v4u){cvtpk_s(p1[0], p1[1]), cvtpk_s(p1[2], p1[3]), cvtpk_s(p1[4], p1[5]), cvtpk_s(p1[6], p1[7])};
        pw3 = (v4u){cvtpk_s(p1[8], p1[9]), cvtpk_s(p1[10], p1[11]), cvtpk_s(p1[12], p1[13]), cvtpk_s(p1[14], p1[15])};
        const bf16x8 pa0 = __builtin_bit_cast(bf16x8, pw0), pa1 = __builtin_bit_cast(bf16x8, pw1), pa2 = __builtin_bit_cast(bf16x8, pw2), pa3 = __builtin_bit_cast(bf16x8, pw3);
        const LAS unsigned char* vb = Vb + ((lane >> 4) & 1) * 32 + (lane & 3) * 8 + (4 * hi + ((lane & 15) >> 2)) * 64;
#pragma unroll
        for (int d0 = 0; d0 < 4; ++d0) {
            const s16x4 l0 = vtr(vb + (d0 * 4 + 0) * 1024), h0 = vtr(vb + (d0 * 4 + 0) * 1024 + 512), l1 = vtr(vb + (d0 * 4 + 1) * 1024), h1 = vtr(vb + (d0 * 4 + 1) * 1024 + 512);
            const s16x4 l2 = vtr(vb + (d0 * 4 + 2) * 1024), h2 = vtr(vb + (d0 * 4 + 2) * 1024 + 512), l3 = vtr(vb + (d0 * 4 + 3) * 1024), h3 = vtr(vb + (d0 * 4 + 3) * 1024 + 512);
            o[d0] = MFMA32(pa0, VFRAG(l0, h0), o[d0]); o[d0] = MFMA32(pa1, VFRAG(l1, h1), o[d0]); o[d0] = MFMA32(pa2, VFRAG(l2, h2), o[d0]); o[d0] = MFMA32(pa3, VFRAG(l3, h3), o[d0]);
        }
    }
    __syncthreads();
    LAS float* RED = (LAS float*)ring + rg * 4096;
    LAS float* REDd = (LAS float*)(ring + 65536) + rg * 64;
    if (kh == 1) {
#pragma unroll
        for (int d0 = 0; d0 < 4; ++d0)
#pragma unroll
            for (int r = 0; r < 16; ++r) RED[(d0 * 16 + r) * 64 + lane] = o[d0][r];
        REDd[lane] = den;
    }
    __syncthreads();
    if (kh == 0) {
#pragma unroll
        for (int d0 = 0; d0 < 4; ++d0)
#pragma unroll
            for (int r = 0; r < 16; ++r) o[d0][r] += RED[(d0 * 16 + r) * 64 + lane];
        den += REDd[lane];
        den += __shfl_xor(den, 32);
        const float f = 1.0f / fmaxf(fabsf(den), __expf(-mq));
        if (hi == 0) wsf[r32] = f;
        LDS_WAIT(); asm volatile("" ::: "memory");
        LAS float* stg = RED;
#pragma unroll
        for (int r = 0; r < 16; ++r) { const int qrow = crow(r, hi); const float rl = wsf[qrow];
#pragma unroll
            for (int d0 = 0; d0 < 4; ++d0) stg[qrow * 128 + 32 * d0 + r32] = o[d0][r] * rl; }
        LDS_WAIT(); asm volatile("" ::: "memory");
#pragma unroll
        for (int i = 0; i < 8; ++i) { const int id = i * 64 + lane, row = id >> 4, ch = id & 15; const int m = t0 + 128 * jb + 32 * rg + row;
            const f32x4 a0 = *(const LAS f32x4*)(stg + row * 128 + 8 * ch), a1 = *(const LAS f32x4*)(stg + row * 128 + 8 * ch + 4);
            const v4u g = *(const GAS v4u*)(PROJ + (size_t)m * NPROJ + PC_OM + 128 * h + 8 * ch);
            float y[8] = {a0.x * sigmoidf_(bflo(g.x)), a0.y * sigmoidf_(bfhi(g.x)), a0.z * sigmoidf_(bflo(g.y)), a0.w * sigmoidf_(bfhi(g.y)), a1.x * sigmoidf_(bflo(g.z)), a1.y * sigmoidf_(bfhi(g.z)), a1.z * sigmoidf_(bflo(g.w)), a1.w * sigmoidf_(bfhi(g.w))};
            float ssq = 0.f;
#pragma unroll
            for (int e = 0; e < 8; ++e) ssq += y[e] * y[e];
            v4u ov; ov.x = pk2(y[0], y[1]); ov.y = pk2(y[2], y[3]); ov.z = pk2(y[4], y[5]); ov.w = pk2(y[6], y[7]);
            *(GAS v4u*)(MIX + (size_t)m * 1024 + 128 * h + 8 * ch) = ov;
            ssq += __shfl_xor(ssq, 1); ssq += __shfl_xor(ssq, 2); ssq += __shfl_xor(ssq, 4); ssq += __shfl_xor(ssq, 8);
            if (ch == 0) SSQ[(size_t)m * 8 + h] = ssq; }
    }
}
__device__ __forceinline__ void mlstm_unit(Frame& F, int b, int h, int j) {
    LAS float* Cs = (LAS float*)(F.lds + SP_CS); LAS float* RM = (LAS float*)(F.lds + SP_RM); LAS float* Wt = (LAS float*)(F.lds + SP_WT);
    const float* GT = (const float*)(F.ws + WS_GATES);
    const int tid = F.tid, lane = F.lane, wave = F.wave, t0 = b * SEQ, jA = j, jB = 15 - j, n = 128 * (jB + 1);
    __syncthreads();
    {
        float lf[4], ig[4];
#pragma unroll
        for (int e = 0; e < 4; ++e) { const int idx = 4 * tid + e; if (idx < n) { lf[e] = GT[(size_t)(t0 + idx) * 8 + 4 + h]; ig[e] = GT[(size_t)(t0 + idx) * 8 + h]; } else { lf[e] = 0.f; ig[e] = -INFINITY; } }
        float cB[4]; cB[0] = lf[0]; cB[1] = cB[0] + lf[1]; cB[2] = cB[1] + lf[2]; cB[3] = cB[2] + lf[3];
        const float tot = cB[3]; float inc = tot;
#pragma unroll
        for (int o = 1; o < 64; o <<= 1) { const float t = __shfl_up(inc, o); if (lane >= o) inc += t; }
        if (lane == 63) Wt[wave] = inc;
        __syncthreads();
        float pre = inc - tot;
        for (int w = 0; w < wave; ++w) pre += Wt[w];
        float cc[4], cm[4];
#pragma unroll
        for (int e = 0; e < 4; ++e) { cB[e] += pre; cc[e] = ig[e] - cB[e]; }
        cm[0] = cc[0]; cm[1] = fmaxf(cm[0], cc[1]); cm[2] = fmaxf(cm[1], cc[2]); cm[3] = fmaxf(cm[2], cc[3]);
        float minc = cm[3];
#pragma unroll
        for (int o = 1; o < 64; o <<= 1) { const float t = __shfl_up(minc, o); if (lane >= o) minc = fmaxf(minc, t); }
        __syncthreads();
        if (lane == 63) Wt[wave] = minc;
        __syncthreads();
        float mpre = __shfl_up(minc, 1); if (lane == 0) mpre = -INFINITY;
        for (int w = 0; w < wave; ++w) mpre = fmaxf(mpre, Wt[w]);
#pragma unroll
        for (int e = 0; e < 4; ++e) { const int idx = 4 * tid + e; if (idx < n) { const float cmx = fmaxf(mpre, cm[e]); const float mt = cB[e] + fmaxf(0.f, cmx); Cs[idx] = cc[e] * LOG2E;
            if (idx >= 128 * jA && idx < 128 * jA + 128) { RM[(idx - 128 * jA) * 2] = (cB[e] - mt) * LOG2E; RM[(idx - 128 * jA) * 2 + 1] = mt; }
            if (idx >= 128 * jB) { RM[256 + (idx - 128 * jB) * 2] = (cB[e] - mt) * LOG2E; RM[256 + (idx - 128 * jB) * 2 + 1] = mt; } } }
    }
    __syncthreads();
    mlstm_block(F, b, h, jA, RM);
    mlstm_block(F, b, h, jB, RM + 256);
}

constexpr float SB_THR2 = -150.0f;
__device__ __forceinline__ void sb_dma(LAS unsigned char* buf, const bf16* PROJ, int t0, int h, int kt, int w, int lane) {
    glds16(PROJ + (size_t)(t0 + 64 * kt + lane) * NPROJ + PC_KSB + 64 * h + 8 * w, buf + w * 1024);
    glds16(PROJ + (size_t)(t0 + 64 * kt + 16 * (w & 3) + (lane >> 2)) * NPROJ + PC_VSB + 64 * h + 32 * (w >> 2) + 8 * (lane & 3), buf + 8192 + w * 1024);
}
__device__ __forceinline__ void sb_unit(Frame& F, int b, int h, int qb) {
    const int lane = F.lane, w = F.wave, r32 = lane & 31, hi = lane >> 5;
    LAS unsigned char* ring = F.lds + RING_OFF;
    volatile LAS unsigned* flags = (volatile LAS unsigned*)(F.lds + SP_FLAG);
    const bf16* PROJ = (const bf16*)(F.ws + WS_PROJ); bf16* MIX = (bf16*)(F.ws + WS_MIX); float* SSQ = (float*)(F.ws + WS_SSQ);
    const int t0 = b * SEQ, q0w = 256 * qb + 32 * w;
    bf16x8 qr[4];
    { const bf16* Qp = PROJ + (size_t)(t0 + q0w + r32) * NPROJ + PC_QSB + 64 * h + 8 * hi;
#pragma unroll
      for (int d0 = 0; d0 < 4; ++d0) qr[d0] = *(const GAS bf16x8*)(Qp + 16 * d0); }
    f32x16 o[2]; float run = 0.f; bool wdone = false;
    o[0] = (f32x16){0.f, 0.f, 0.f, 0.f, 0.f, 0.f, 0.f, 0.f, 0.f, 0.f, 0.f, 0.f, 0.f, 0.f, 0.f, 0.f}; o[1] = o[0];
    const int kt_top = 4 * qb + 3;
    __syncthreads();
    sb_dma(ring, PROJ, t0, h, kt_top, w, lane);
    int it = 0;
    for (int kt = kt_top; kt >= 0; --kt, ++it) {
        __syncthreads();
        if (it > 0) { const volatile LAS unsigned* fl = flags + ((it - 1) & 1) * 8; const unsigned all = fl[0] & fl[1] & fl[2] & fl[3] & fl[4] & fl[5] & fl[6] & fl[7]; if (__builtin_amdgcn_readfirstlane(all)) break; }
        if (kt > 0) sb_dma(ring + ((it + 1) & 1) * 16384, PROJ, t0, h, kt - 1, w, lane);
        const bool active = !wdone && (64 * kt < q0w + 31);
        if (active) {
            const LAS unsigned char* Kb = ring + (it & 1) * 16384; const LAS unsigned char* Vb = Kb + 8192;
            f32x16 p0 = (f32x16){0.f, 0.f, 0.f, 0.f, 0.f, 0.f, 0.f, 0.f, 0.f, 0.f, 0.f, 0.f, 0.f, 0.f, 0.f, 0.f}, p1 = p0;
            { const LAS unsigned char* kb = Kb + hi * 1024 + r32 * 16;
#pragma unroll
              for (int d0 = 0; d0 < 4; ++d0) { const bf16x8 b0 = *(const LAS bf16x8*)(kb + d0 * 2048), b1 = *(const LAS bf16x8*)(kb + d0 * 2048 + 512);
                  p0 = MFMA32(b0, qr[d0], p0); p1 = MFMA32(b1, qr[d0], p1); } }
            const int lim = q0w + r32 - 64 * kt - 4 * hi;
            float Lr[32], ls[32];
#pragma unroll
            for (int r = 0; r < 16; ++r) { const int kv = (r & 3) + 8 * (r >> 2);
                { const float z2 = p0[r] * (0.125f * LOG2E); const float sp = fmaxf(z2, 0.f) + __builtin_amdgcn_logf(1.0f + __builtin_amdgcn_exp2f(-fabsf(z2))); const bool ok = kv < lim; Lr[r] = ok ? -sp : 0.f; ls[r] = ok ? z2 - sp : -INFINITY; }
                { const float z2 = p1[r] * (0.125f * LOG2E); const float sp = fmaxf(z2, 0.f) + __builtin_amdgcn_logf(1.0f + __builtin_amdgcn_exp2f(-fabsf(z2))); const bool ok = kv + 32 < lim; Lr[16 + r] = ok ? -sp : 0.f; ls[16 + r] = ok ? z2 - sp : -INFINITY; } }
            float seg[8], os[8], aft[8];
#pragma unroll
            for (int g = 0; g < 8; ++g) seg[g] = (Lr[4 * g] + Lr[4 * g + 1]) + (Lr[4 * g + 2] + Lr[4 * g + 3]);
            os[7] = 0.f;
#pragma unroll
            for (int g = 6; g >= 0; --g) os[g] = os[g + 1] + seg[g + 1];
            const float own_tot = os[0] + seg[0];
#pragma unroll
            for (int g = 0; g < 8; ++g) { const float snd = hi ? os[g] + seg[g] : os[g]; aft[g] = run + os[g] + __shfl_xor(snd, 32); }
            const float tile_tot = own_tot + __shfl_xor(own_tot, 32);
#pragma unroll
            for (int g = 0; g < 8; ++g) { const float e3 = aft[g], e2 = e3 + Lr[4 * g + 3], e1 = e2 + Lr[4 * g + 2], e0 = e1 + Lr[4 * g + 1];
                ls[4 * g + 3] = __builtin_amdgcn_exp2f(ls[4 * g + 3] + e3); ls[4 * g + 2] = __builtin_amdgcn_exp2f(ls[4 * g + 2] + e2); ls[4 * g + 1] = __builtin_amdgcn_exp2f(ls[4 * g + 1] + e1); ls[4 * g] = __builtin_amdgcn_exp2f(ls[4 * g] + e0); }
            run += tile_tot;
            v4u pw0, pw1, pw2, pw3;
            pw0 = (v4u){cvtpk_s(ls[0], ls[1]), cvtpk_s(ls[2], ls[3]), cvtpk_s(ls[4], ls[5]), cvtpk_s(ls[6], ls[7])};
            pw1 = (v4u){cvtpk_s(ls[8], ls[9]), cvtpk_s(ls[10], ls[11]), cvtpk_s(ls[12], ls[13]), cvtpk_s(ls[14], ls[15])};
            pw2 = (v4u){cvtpk_s(ls[16], ls[17]), cvtpk_s(ls[18], ls[19]), cvtpk_s(ls[20], ls[21]), cvtpk_s(ls[22], ls[23])};
            pw3 = (v4u){cvtpk_s(ls[24], ls[25]), cvtpk_s(ls[26], ls[27]), cvtpk_s(ls[28], ls[29]), cvtpk_s(ls[30], ls[31])};
            const bf16x8 pa0 = __builtin_bit_cast(bf16x8, pw0), pa1 = __builtin_bit_cast(bf16x8, pw1), pa2 = __builtin_bit_cast(bf16x8, pw2), pa3 = __builtin_bit_cast(bf16x8, pw3);
            const LAS unsigned char* vb = Vb + ((lane >> 4) & 1) * 32 + (lane & 3) * 8 + (4 * hi + ((lane & 15) >> 2)) * 64;
#pragma unroll
            for (int d0 = 0; d0 < 2; ++d0) {
                const s16x4 l0 = vtr(vb + (d0 * 4 + 0) * 1024), h0 = vtr(vb + (d0 * 4 + 0) * 1024 + 512), l1 = vtr(vb + (d0 * 4 + 1) * 1024), h1 = vtr(vb + (d0 * 4 + 1) * 1024 + 512);
                const s16x4 l2 = vtr(vb + (d0 * 4 + 2) * 1024), h2 = vtr(vb + (d0 * 4 + 2) * 1024 + 512), l3 = vtr(vb + (d0 * 4 + 3) * 1024), h3 = vtr(vb + (d0 * 4 + 3) * 1024 + 512);
                o[d0] = MFMA32(pa0, VFRAG(l0, h0), o[d0]); o[d0] = MFMA32(pa1, VFRAG(l1, h1), o[d0]); o[d0] = MFMA32(pa2, VFRAG(l2, h2), o[d0]); o[d0] = MFMA32(pa3, VFRAG(l3, h3), o[d0]);
            }
            wdone = __all(run < SB_THR2);
        }
        if (lane == 0) flags[(it & 1) * 8 + w] = wdone ? 1u : 0u;
    }
    __syncthreads();
    {
        LAS float* stg = (LAS float*)ring + w * 2048;
#pragma unroll
        for (int r = 0; r < 16; ++r) { const int qrow = crow(r, hi);
#pragma unroll
            for (int d0 = 0; d0 < 2; ++d0) stg[qrow * 64 + 32 * d0 + r32] = o[d0][r]; }
        LDS_WAIT(); asm volatile("" ::: "memory");
#pragma unroll
        for (int i = 0; i < 4; ++i) { const int id = i * 64 + lane, row = id >> 3, ch = id & 7; const int m = t0 + q0w + row;
            const f32x4 a0 = *(const LAS f32x4*)(stg + row * 64 + 8 * ch), a1 = *(const LAS f32x4*)(stg + row * 64 + 8 * ch + 4);
            float ssq = (a0.x * a0.x + a0.y * a0.y) + (a0.z * a0.z + a0.w * a0.w) + (a1.x * a1.x + a1.y * a1.y) + (a1.z * a1.z + a1.w * a1.w);
            v4u ov; ov.x = pk2(a0.x, a0.y); ov.y = pk2(a0.z, a0.w); ov.z = pk2(a1.x, a1.y); ov.w = pk2(a1.z, a1.w);
            *(GAS v4u*)(MIX + (size_t)m * 1024 + 512 + 64 * h + 8 * ch) = ov;
            ssq += __shfl_xor(ssq, 1); ssq += __shfl_xor(ssq, 2); ssq += __shfl_xor(ssq, 4);
            if (ch == 0) SSQ[(size_t)m * 8 + 4 + h] = ssq; }
    }
}

__device__ __forceinline__ void p_mixers(Frame& F) {
    for (int v = F.vcu; v < 256; v += F.G) {
        const int bh = v >> 3, s = v & 7, b = bh >> 2, h = bh & 3;
#ifdef MLSTM_SCALAR
        for (int i = 0; i < 4; ++i) { const int qb = (i == 0) ? s : (i == 1) ? 15 - s : (i == 2) ? 16 + s : 31 - s; mlstm_unit_scalar(F, b, h, qb); }
#else
        mlstm_unit(F, b, h, s);
#endif
#ifdef SB_SCALAR
        for (int i = 0; i < 4; ++i) { const int qb = (i == 0) ? s : (i == 1) ? 15 - s : (i == 2) ? 16 + s : 31 - s; sb_unit_scalar(F, b, h, qb); }
#else
        sb_unit(F, b, h, s);
#endif
    }
    __syncthreads();
}
__device__ __forceinline__ void p_groupnorm(Frame& F) {
    bf16* MIX = (bf16*)(F.ws + WS_MIX); const float* SSQ = (const float*)(F.ws + WS_SSQ);
    const int gw = F.vcu * NWAVES + F.wave, NGW = F.G * NWAVES;
    for (int m = gw; m < M; m += NGW) {
        const f32x4 a = *(const f32x4*)(SSQ + (size_t)m * 8), c = *(const f32x4*)(SSQ + (size_t)m * 8 + 4);
        const float rm = 1.0f / sqrtf(((a.x + a.y) + (a.z + a.w)) * (1.0f / 512.0f) + EPS), rs = 1.0f / sqrtf(((c.x + c.y) + (c.z + c.w)) * (1.0f / 256.0f) + EPS);
#pragma unroll
        for (int i = 0; i < 2; ++i) { const int ch = F.lane + 64 * i; if (ch < 96) { GAS v4u* p = (GAS v4u*)(MIX + (size_t)m * 1024 + ch * 8); const v4u x = *p; const float r = ch < 64 ? rm : rs;
            v4u o; o.x = pk2(bflo(x.x) * r, bfhi(x.x) * r); o.y = pk2(bflo(x.y) * r, bfhi(x.y) * r); o.z = pk2(bflo(x.z) * r, bfhi(x.z) * r); o.w = pk2(bflo(x.w) * r, bfhi(x.w) * r); *p = o; } }
    }
}
__device__ __forceinline__ void p_rowpass(Frame& F, const float* base, const float* g1, const float* g2, int lg, bool with_gates) {
    const float* Y = (const float*)(F.ws + WS_Y);
    const int gw = F.vcu * NWAVES + F.wave, NGW = F.G * NWAVES;
    for (int m = gw; m < M; m += NGW) {
        const GAS f32x4* yr = (const GAS f32x4*)(Y + (size_t)m * DM) + F.lane; const GAS f32x4* br = (const GAS f32x4*)(base + (size_t)m * DM) + F.lane;
        f32x4 y[4], v[4]; float ss = 0.f;
#pragma unroll
        for (int j = 0; j < 4; ++j) { y[j] = yr[64 * j]; v[j] = br[64 * j]; ss += (y[j].x * y[j].x + y[j].y * y[j].y) + (y[j].z * y[j].z + y[j].w * y[j].w); }
        const float rstd = 1.0f / sqrtf(wave_sum(ss) * (1.0f / DM) + EPS);
        GAS f32x4* orow = (GAS f32x4*)(F.out + (size_t)m * DM) + F.lane;
#pragma unroll
        for (int j = 0; j < 4; ++j) { const f32x4 gg = *(const f32x4*)(g1 + 4 * F.lane + 256 * j); v[j] = v[j] + y[j] * rstd * gg; orow[64 * j] = v[j]; }
        if (g2) row_norm_store(F, v, g2, lg, m, with_gates);
    }
}
__device__ __forceinline__ void p_act(Frame& F, int l, int f_off) {
    const bf16* UP = (const bf16*)(F.ws + WS_UP); bf16* ACT = (bf16*)(F.ws + WS_ACT);
    const float* cw = inp(F, 16) + (size_t)l * 3 * NUP; const float* cb = inp(F, 17) + (size_t)l * NUP;
    const int gt = F.vcu * (NWAVES * 64) + F.tid, NGT = F.G * NWAVES * 64;
    for (int it = gt; it < M * 176; it += NGT) {
        const int m = it / 176, c = it % 176, j = c >> 4, ii = (c & 15) * 8, s = m & (SEQ - 1);
        const int f = f_off + 128 * j + ii;
        float ga[8], va[8];
#pragma unroll
        for (int e = 0; e < 8; ++e) { ga[e] = cb[f + e]; va[e] = cb[DFF + f + e]; }
#pragma unroll
        for (int jj = 0; jj < 3; ++jj) { if (s - 2 + jj >= 0) { const bf16* rp = UP + (size_t)(m - 2 + jj) * NUPH + 256 * j + ii; const v4u pg = *(const GAS v4u*)rp, pv = *(const GAS v4u*)(rp + 128);
            const float* wg = cw + (size_t)jj * NUP + f; const float* wv = wg + DFF;
            ga[0] += wg[0] * bflo(pg.x); ga[1] += wg[1] * bfhi(pg.x); ga[2] += wg[2] * bflo(pg.y); ga[3] += wg[3] * bfhi(pg.y); ga[4] += wg[4] * bflo(pg.z); ga[5] += wg[5] * bfhi(pg.z); ga[6] += wg[6] * bflo(pg.w); ga[7] += wg[7] * bfhi(pg.w);
            va[0] += wv[0] * bflo(pv.x); va[1] += wv[1] * bfhi(pv.x); va[2] += wv[2] * bflo(pv.y); va[3] += wv[3] * bfhi(pv.y); va[4] += wv[4] * bflo(pv.z); va[5] += wv[5] * bfhi(pv.z); va[6] += wv[6] * bflo(pv.w); va[7] += wv[7] * bfhi(pv.w); } }
        float o[8];
#pragma unroll
        for (int e = 0; e < 8; ++e) { const float x = ga[e]; const float u2 = 1.5957691216057308f * (x + 0.044715f * x * x * x); o[e] = x * sigmoidf_(u2) * va[e]; }
        v4u ov; ov.x = pk2(o[0], o[1]); ov.y = pk2(o[2], o[3]); ov.z = pk2(o[4], o[5]); ov.w = pk2(o[6], o[7]);
        *(GAS v4u*)(ACT + (size_t)m * DFF + f) = ov;
    }
}


#define GRID_BAR() xcd_barrier(bar)
template <int l> __device__ __forceinline__ void layer_fwd(Frame& F, const XcdBarrier& bar) {
    bf16* XN = (bf16*)(F.ws + WS_XN); bf16* PROJ = (bf16*)(F.ws + WS_PROJ); bf16* MIX = (bf16*)(F.ws + WS_MIX); bf16* UP = (bf16*)(F.ws + WS_UP); bf16* ACT = (bf16*)(F.ws + WS_ACT); float* Y = (float*)(F.ws + WS_Y);
    bf16* Win_t = (bf16*)(F.ws + WS_WIN); bf16* Wout_t = (bf16*)(F.ws + WS_WOUT); bf16* Wup_t = (bf16*)(F.ws + WS_WUP); bf16* Wdn_t = (bf16*)(F.ws + WS_WDN);

        {
            pg8::Gemm g{XN, Win_t, M, NPROJ, DM}; pg8::StaticOrder S; S.init(M, NPROJ, F.G, (int)blockIdx.x);
            pg8::EpiBf16 E{PROJ, NPROJ};
            pg8::gemm_phase<pg8::EpiBf16, pg8::StaticOrder, true, true>(F.lds + RING_OFF, g, S, E);
        }
        GRID_BAR();
#ifndef NO_P_CONV_POOL
        p_conv_pool(F, l);
#endif
        GRID_BAR();
#ifndef NO_P_MIXERS
        p_mixers(F);
#endif
        GRID_BAR();
#ifndef NO_P_GROUPNORM
        p_groupnorm(F);
#endif
        GRID_BAR();
        {
            pg8::Gemm g{MIX, Wout_t, M, DM, DM}; pg8::StaticOrder S; S.init(M, DM, F.G, (int)blockIdx.x);
            pg8::EpiF32 E{Y, DM};
            pg8::gemm_phase<pg8::EpiF32, pg8::StaticOrder, true, true>(F.lds + RING_OFF, g, S, E);
        }
        GRID_BAR();
        p_rowpass(F, l == 0 ? inp(F, 0) : F.out, inp(F, 13) + l * DM, inp(F, 14) + l * DM, l, false);
        GRID_BAR();
        {
            constexpr int hf = 0;
            {
                pg8::Gemm g{XN, Wup_t + (size_t)hf * NUPH * DM, M, NUPH, DM}; pg8::StaticOrder S; S.init(M, NUPH, F.G, (int)blockIdx.x);
                pg8::EpiBf16 E{UP, NUPH};
                pg8::gemm_phase<pg8::EpiBf16, pg8::StaticOrder, true, true>(F.lds + RING_OFF, g, S, E);
            }
            GRID_BAR();
    #ifndef NO_P_ACT
        p_act(F, l, hf * 1408);
#endif
            GRID_BAR();
        }
        {
            constexpr int hf = 1;
            {
                pg8::Gemm g{XN, Wup_t + (size_t)hf * NUPH * DM, M, NUPH, DM}; pg8::StaticOrder S; S.init(M, NUPH, F.G, (int)blockIdx.x);
                pg8::EpiBf16 E{UP, NUPH};
                pg8::gemm_phase<pg8::EpiBf16, pg8::StaticOrder, true, true>(F.lds + RING_OFF, g, S, E);
            }
            GRID_BAR();
    #ifndef NO_P_ACT
        p_act(F, l, hf * 1408);
#endif
            GRID_BAR();
        }
        {
            pg8::Gemm g{ACT, Wdn_t, M, DM, DFF}; pg8::StaticOrder S; S.init(M, DM, F.G, (int)blockIdx.x);
            pg8::EpiF32 E{Y, DM};
            pg8::gemm_phase<pg8::EpiF32, pg8::StaticOrder, true, true>(F.lds + RING_OFF, g, S, E);
        }
        GRID_BAR();
        if (l + 1 < DEPTH) {
            p_rowpass(F, F.out, inp(F, 19) + l * DM, inp(F, 1) + (l + 1) * DM, l + 1, true);
            convert_weights(F, l + 1);
            GRID_BAR();
        } else {
            p_rowpass(F, F.out, inp(F, 19) + l * DM, nullptr, 0, false);
        }
    }
#undef GRID_BAR
struct Args { const float* in[20]; float* out; unsigned char* ws; };
__global__ void __launch_bounds__(NWAVES * 64, 2) mega_fwd(Args args) {
    extern __shared__ __attribute__((aligned(16))) unsigned char lds[];
    Frame F;
    F.lds = (LAS unsigned char*)lds;
    F.MISC = (volatile LAS unsigned*)(F.lds + MISC_OFF);
    F.tid = threadIdx.x; F.lane = F.tid & 63; F.wave = __builtin_amdgcn_readfirstlane(F.tid >> 6);
    F.G = gridDim.x; { const int bx = blockIdx.x; F.vcu = (F.G % 8 == 0) ? (bx % 8) * (F.G / 8) + bx / 8 : bx; }
    F.ws = args.ws; F.out = args.out; F.ctl = (gu32*)(args.ws + WS_CTL);
    for (int u = F.tid; u < (LDS_BYTES - LDSCTL_OFF) / 4; u += NWAVES * 64) ((LAS unsigned*)(F.lds + LDSCTL_OFF))[u] = 0u;
    __syncthreads();
    if (F.tid == 0) { LAS unsigned long long* t = (LAS unsigned long long*)(F.lds + LDSCTL_OFF);
#define PUT_(i) t[i] = (unsigned long long)args.in[i];
        PUT_(0) PUT_(1) PUT_(2) PUT_(3) PUT_(4) PUT_(5) PUT_(6) PUT_(7) PUT_(8) PUT_(9) PUT_(10) PUT_(11) PUT_(12) PUT_(13) PUT_(14) PUT_(15) PUT_(16) PUT_(17) PUT_(18) PUT_(19)
#undef PUT_
    }
    __syncthreads();
    XcdBarrier bar = xcd_barrier_post((unsigned*)(F.ctl + CW_BAR), F.MISC + 8);
#define GRID_BAR() xcd_barrier(bar)
#ifndef NO_P_PROLOGUE
        p_prologue(F);
#endif
    GRID_BAR();
    layer_fwd<0>(F, bar);
    layer_fwd<1>(F, bar);
#undef GRID_BAR
}

extern "C" void kernel_launch(void* const* d_in, const int* in_sizes, int n_in, void* d_out, int out_size, void* d_ws, size_t ws_size, hipStream_t stream) {
    static int grid = 0;
    if (grid == 0) {
        if (n_in != 20 || in_sizes[0] != M * DM || out_size != M * DM || ws_size < WS_END) { fprintf(stderr, "kernel_launch: unexpected shapes (n_in %d, in0 %d, out %d, ws %zu)\n", n_in, n_in > 0 ? in_sizes[0] : -1, out_size, ws_size); grid = -1; return; }
        int dev = 0, cus = 0, per_cu = 0;
        if (hipGetDevice(&dev) != hipSuccess || hipDeviceGetAttribute(&cus, hipDeviceAttributeMultiprocessorCount, dev) != hipSuccess) { grid = -1; return; }
        if (hipFuncSetAttribute((const void*)mega_fwd, hipFuncAttributeMaxDynamicSharedMemorySize, LDS_BYTES) != hipSuccess) { fprintf(stderr, "kernel_launch: hipFuncSetAttribute failed\n"); grid = -1; return; }
        if (hipOccupancyMaxActiveBlocksPerMultiprocessor(&per_cu, (const void*)mega_fwd, NWAVES * 64, LDS_BYTES) != hipSuccess || per_cu < 1) fprintf(stderr, "kernel_launch: occupancy query reports %d blocks per CU\n", per_cu);
        (void)hipGetLastError();
        grid = cus;
    }
    if (grid < 0) return;
    if (hipMemsetAsync((char*)d_ws + WS_CTL, 0, CTL_ZERO_BYTES, stream) != hipSuccess) { fprintf(stderr, "kernel_launch: hipMemsetAsync failed\n"); return; }
    Args a{};
    for (int i = 0; i < 20; ++i) a.in[i] = (const float*)d_in[i];
    a.out = (float*)d_out; a.ws = (unsigned char*)d_ws;
    hipLaunchKernelGGL(mega_fwd, dim3(grid), dim3(NWAVES * 64), LDS_BYTES, stream, a);
    const hipError_t le = hipPeekAtLastError();
    if (le != hipSuccess) fprintf(stderr, "kernel_launch: launch failed: %s\n", hipGetErrorName(le));
}
```
